# Optimizing an MI355X kernel written in HIP

```python
import math
import jax
import jax.numpy as jnp
from jax import lax
import numpy as np

D_MODEL = 1024
BATCH = 4
SEQ = 4096
DEPTH = 1

MIX_WIDTH = D_MODEL
HEAD_DIM = 64
ATTN_WIDTH = MIX_WIDTH // 2
N_Q_HEADS = ATTN_WIDTH // HEAD_DIM
N_KV_HEADS = max(1, N_Q_HEADS // 4)
Q_PER_KV = N_Q_HEADS // N_KV_HEADS
KV_WIDTH = N_KV_HEADS * HEAD_DIM
WINDOW = 128
ATTN_BLOCK = 128
HALO = -(-WINDOW // ATTN_BLOCK)
ROPE_THETA = 10000.0
MASK_VALUE = -1e30

SSM_WIDTH = MIX_WIDTH - ATTN_WIDTH
SSM_CH_PER_GROUP = 16
SSM_GROUPS = SSM_WIDTH // SSM_CH_PER_GROUP
SSM_STATE = 64
DT_MIN = 0.001
DT_MAX = 0.1

IN_WIDTH = ATTN_WIDTH + 2 * KV_WIDTH + SSM_WIDTH

N_EXPERTS = 32
TOP_K = 4
D_FF = D_MODEL
SWIGLU_LIMIT = 7.0
SWIGLU_ALPHA = 1.702
MOE_BLOCK = 512

RMS_EPS = 1e-6

kernel_name = "hymba_swa_s5_moe_adaln_layer"


def rms_norm(x, g):
    xf = x.astype(jnp.float32)
    y = xf * lax.rsqrt(jnp.mean(xf * xf, axis=-1, keepdims=True) + RMS_EPS)
    return (y * g.astype(jnp.float32)).astype(x.dtype)


def rope(t, pos):
    half = HEAD_DIM // 2
    inv_freq = ROPE_THETA ** (-jnp.arange(half, dtype=jnp.float32) * 2.0 / HEAD_DIM)
    ang = pos.astype(jnp.float32)[:, None] * inv_freq[None, :]
    cos = jnp.cos(ang)[None, :, None, :]
    sin = jnp.sin(ang)[None, :, None, :]
    tf = t.astype(jnp.float32)
    t1, t2 = tf[..., :half], tf[..., half:]
    return jnp.concatenate([t1 * cos - t2 * sin, t2 * cos + t1 * sin], axis=-1).astype(t.dtype)


def windowed_gqa(q, k, v, sink):
    bsz, s, _ = q.shape
    nb = s // ATTN_BLOCK
    kb_len = (2 * HALO + 1) * ATTN_BLOCK
    pos = jnp.arange(s, dtype=jnp.int32)
    q = rope(q.reshape(bsz, s, N_Q_HEADS, HEAD_DIM), pos)
    k = rope(k.reshape(bsz, s, N_KV_HEADS, HEAD_DIM), pos)
    v = v.reshape(bsz, s, N_KV_HEADS, HEAD_DIM)
    pad = HALO * ATTN_BLOCK
    kp = jnp.pad(k, ((0, 0), (pad, pad), (0, 0), (0, 0))).reshape(bsz, nb + 2 * HALO, ATTN_BLOCK, N_KV_HEADS, HEAD_DIM)
    vp = jnp.pad(v, ((0, 0), (pad, pad), (0, 0), (0, 0))).reshape(bsz, nb + 2 * HALO, ATTN_BLOCK, N_KV_HEADS, HEAD_DIM)
    kb = jnp.concatenate([kp[:, o:o + nb] for o in range(2 * HALO + 1)], axis=2)
    vb = jnp.concatenate([vp[:, o:o + nb] for o in range(2 * HALO + 1)], axis=2)
    qb = q.reshape(bsz, nb, ATTN_BLOCK, N_KV_HEADS, Q_PER_KV, HEAD_DIM)
    scores = jnp.einsum('bnqhgd,bnkhd->bnhgqk', qb, kb).astype(jnp.float32) * (HEAD_DIM ** -0.5)
    blk = jnp.arange(nb, dtype=jnp.int32)[:, None]
    qpos = blk * ATTN_BLOCK + jnp.arange(ATTN_BLOCK, dtype=jnp.int32)[None, :]
    kpos = (blk - HALO) * ATTN_BLOCK + jnp.arange(kb_len, dtype=jnp.int32)[None, :]
    valid = ((jnp.abs(qpos[:, :, None] - kpos[:, None, :]) <= WINDOW)
             & (kpos >= 0)[:, None, :] & (kpos < s)[:, None, :])
    scores = jnp.where(valid[None, :, None, None], scores, MASK_VALUE)
    sink_l = sink.astype(jnp.float32).reshape(1, 1, N_KV_HEADS, Q_PER_KV, 1, 1)
    m = jnp.maximum(jnp.max(scores, axis=-1, keepdims=True), sink_l)
    p = jnp.exp(scores - m)
    denom = jnp.sum(p, axis=-1, keepdims=True) + jnp.exp(sink_l - m)
    probs = (p / denom).astype(v.dtype)
    out = jnp.einsum('bnhgqk,bnkhd->bnqhgd', probs, vb)
    return out.reshape(bsz, s, ATTN_WIDTH)


def _linear_recurrence_combine(e1, e2):
    a1r, a1i, b1r, b1i = e1
    a2r, a2i, b2r, b2i = e2
    ar = a1r * a2r - a1i * a2i
    ai = a1r * a2i + a1i * a2r
    br = a2r * b1r - a2i * b1i + b2r
    bi = a2r * b1i + a2i * b1r + b2i
    return (ar, ai, br, bi)


def _s5_direction(uf, a_re, a_im, log_dt, b_re, b_im, c_re, c_im, reverse):
    dt = jnp.exp(log_dt)[:, None]
    lr = a_re * dt
    li = a_im * dt
    mag = jnp.exp(lr)
    abar_r = mag * jnp.cos(li)
    abar_i = mag * jnp.sin(li)
    den = a_re * a_re + a_im * a_im
    nr = abar_r - 1.0
    ni = abar_i
    f_r = (nr * a_re + ni * a_im) / den
    f_i = (ni * a_re - nr * a_im) / den
    bb_r = f_r[..., None] * b_re - f_i[..., None] * b_im
    bb_i = f_r[..., None] * b_im + f_i[..., None] * b_re
    bu_r = jnp.einsum('bsgh,gph->bsgp', uf, bb_r)
    bu_i = jnp.einsum('bsgh,gph->bsgp', uf, bb_i)
    a_r = jnp.broadcast_to(abar_r, bu_r.shape)
    a_i = jnp.broadcast_to(abar_i, bu_i.shape)
    _, _, s_r, s_i = lax.associative_scan(_linear_recurrence_combine, (a_r, a_i, bu_r, bu_i), axis=1, reverse=reverse)
    return jnp.einsum('bsgp,ghp->bsgh', s_r, c_re) - jnp.einsum('bsgp,ghp->bsgh', s_i, c_im)


def s5_bidirectional(u, a_re, a_im, log_dt, b_re, b_im, c_re, c_im, d_skip):
    bsz, s, _ = u.shape
    uf = u.astype(jnp.float32).reshape(bsz, s, SSM_GROUPS, SSM_CH_PER_GROUP)
    y = d_skip.astype(jnp.float32).reshape(SSM_GROUPS, SSM_CH_PER_GROUP) * uf
    for direction in range(2):
        y = y + _s5_direction(uf,
                              a_re[direction].astype(jnp.float32), a_im[direction].astype(jnp.float32),
                              log_dt[direction].astype(jnp.float32),
                              b_re[direction].astype(jnp.float32), b_im[direction].astype(jnp.float32),
                              c_re[direction].astype(jnp.float32), c_im[direction].astype(jnp.float32),
                              direction == 1)
    return y.reshape(bsz, s, SSM_WIDTH)


def hybrid_mixer(h, w_in, attn_sink, ssm_a_re, ssm_a_im, ssm_log_dt, ssm_b_re, ssm_b_im,
                 ssm_c_re, ssm_c_im, ssm_d, w_glu, b_glu, g_attn_out, g_ssm_out, w_out):
    proj = h @ w_in
    q = proj[..., :ATTN_WIDTH]
    k = proj[..., ATTN_WIDTH:ATTN_WIDTH + KV_WIDTH]
    v = proj[..., ATTN_WIDTH + KV_WIDTH:ATTN_WIDTH + 2 * KV_WIDTH]
    u = proj[..., ATTN_WIDTH + 2 * KV_WIDTH:]
    y_attn = windowed_gqa(q, k, v, attn_sink)
    y_ssm = s5_bidirectional(u, ssm_a_re, ssm_a_im, ssm_log_dt, ssm_b_re, ssm_b_im, ssm_c_re, ssm_c_im, ssm_d)
    g = jax.nn.gelu(y_ssm).astype(h.dtype)
    y_ssm = g * jax.nn.sigmoid(g @ w_glu + b_glu)
    y = jnp.concatenate([rms_norm(y_attn, g_attn_out), rms_norm(y_ssm, g_ssm_out)], axis=-1)
    return y @ w_out


def moe_ffn(h, w_router, b_router, w_gate_up, b_gate_up, w_down, b_down):
    bsz, s, d = h.shape
    n_tok = bsz * s
    n_assign = n_tok * TOP_K
    hf = h.reshape(n_tok, d)
    logits = (hf @ w_router + b_router).astype(jnp.float32)
    top_logits, top_idx = lax.top_k(logits, TOP_K)
    gates = jax.nn.softmax(top_logits, axis=-1)
    expert_flat = top_idx.reshape(-1)
    gate_flat = gates.reshape(-1)
    token_flat = jnp.arange(n_assign, dtype=jnp.int32) // TOP_K
    order = jnp.argsort(expert_flat)
    sorted_expert = expert_flat[order]
    counts = jnp.bincount(expert_flat, length=N_EXPERTS).astype(jnp.int32)
    padded = (counts + MOE_BLOCK - 1) // MOE_BLOCK * MOE_BLOCK
    ends = jnp.cumsum(counts)
    starts = ends - counts
    pends = jnp.cumsum(padded)
    pstarts = pends - padded
    rank = jnp.arange(n_assign, dtype=jnp.int32) - starts[sorted_expert]
    dest = pstarts[sorted_expert] + rank
    n_rows = (-(-n_assign // MOE_BLOCK) + N_EXPERTS) * MOE_BLOCK
    n_blocks = n_rows // MOE_BLOCK
    row_token = jnp.zeros((n_rows,), jnp.int32).at[dest].set(token_flat[order])
    row_gate = jnp.zeros((n_rows,), jnp.float32).at[dest].set(gate_flat[order])
    block_start = jnp.arange(n_blocks, dtype=jnp.int32) * MOE_BLOCK
    block_expert = jnp.minimum(jnp.searchsorted(pends, block_start, side='right'), N_EXPERTS - 1)
    xs = hf[row_token].reshape(n_blocks, MOE_BLOCK, d)

    def expert_block(args):
        xb, e = args
        gu = xb @ w_gate_up[e] + b_gate_up[e]
        glu, lin = gu[:, :D_FF], gu[:, D_FF:]
        glu = jnp.minimum(glu, SWIGLU_LIMIT)
        lin = jnp.clip(lin, -SWIGLU_LIMIT, SWIGLU_LIMIT)
        act = glu * jax.nn.sigmoid(SWIGLU_ALPHA * glu) * (lin + 1.0)
        return act @ w_down[e] + b_down[e]

    ys = lax.map(expert_block, (xs, block_expert)).reshape(n_rows, d)
    out = jnp.zeros((n_tok, d), ys.dtype).at[row_token].add(ys * row_gate[:, None].astype(ys.dtype))
    return out.reshape(bsz, s, d)


def setup_inputs(seed: int = 0) -> dict:
    key = jax.random.key(seed)
    ks = jax.random.split(key, 32)
    L = DEPTH
    G, P, H = SSM_GROUPS, SSM_STATE, SSM_CH_PER_GROUP

    def nrm(k, shape, scale):
        return jax.random.normal(k, shape, jnp.float32) * scale

    x = nrm(ks[0], (BATCH, SEQ, D_MODEL), 1.0)
    c = nrm(ks[1], (BATCH, D_MODEL), 1.0)
    w_ada = nrm(ks[2], (L, D_MODEL, 6 * D_MODEL), 0.5 * D_MODEL ** -0.5)
    b_ada = nrm(ks[3], (L, 6 * D_MODEL), 0.02)
    g_pre_mix = 1.0 + nrm(ks[4], (L, D_MODEL), 0.05)
    w_in = nrm(ks[5], (L, D_MODEL, IN_WIDTH), D_MODEL ** -0.5)
    attn_sink = nrm(ks[6], (L, N_Q_HEADS), 1.0)
    ssm_a_re = -0.5 + nrm(ks[7], (L, 2, G, P), 0.01)
    ssm_a_im = math.pi * jnp.arange(P, dtype=jnp.float32) + nrm(ks[8], (L, 2, G, P), 0.01)
    ssm_log_dt = math.log(DT_MIN) + jax.random.uniform(ks[9], (L, 2, G), jnp.float32) * (math.log(DT_MAX) - math.log(DT_MIN))
    ssm_b_re = nrm(ks[10], (L, 2, G, P, H), (2 * H) ** -0.5)
    ssm_b_im = nrm(ks[11], (L, 2, G, P, H), (2 * H) ** -0.5)
    ssm_c_re = nrm(ks[12], (L, 2, G, H, P), P ** -0.5)
    ssm_c_im = nrm(ks[13], (L, 2, G, H, P), P ** -0.5)
    ssm_d = nrm(ks[14], (L, SSM_WIDTH), 0.5)
    w_glu = nrm(ks[15], (L, SSM_WIDTH, SSM_WIDTH), SSM_WIDTH ** -0.5)
    b_glu = nrm(ks[16], (L, SSM_WIDTH), 0.02)
    g_attn_out = 1.0 + nrm(ks[17], (L, ATTN_WIDTH), 0.05)
    g_ssm_out = 1.0 + nrm(ks[18], (L, SSM_WIDTH), 0.05)
    w_out = nrm(ks[19], (L, MIX_WIDTH, D_MODEL), MIX_WIDTH ** -0.5)
    g_post_mix = 1.0 + nrm(ks[20], (L, D_MODEL), 0.05)
    g_pre_ffn = 1.0 + nrm(ks[21], (L, D_MODEL), 0.05)
    w_router = nrm(ks[22], (L, D_MODEL, N_EXPERTS), D_MODEL ** -0.5)
    b_router = nrm(ks[23], (L, N_EXPERTS), 0.01)
    w_gate_up = nrm(ks[24], (L, N_EXPERTS, D_MODEL, 2 * D_FF), D_MODEL ** -0.5)
    b_gate_up = nrm(ks[25], (L, N_EXPERTS, 2 * D_FF), 0.02)
    w_down = nrm(ks[26], (L, N_EXPERTS, D_FF, D_MODEL), D_FF ** -0.5)
    b_down = nrm(ks[27], (L, N_EXPERTS, D_MODEL), 0.02)
    g_post_ffn = 1.0 + nrm(ks[28], (L, D_MODEL), 0.05)
    return {"x": x, "c": c, "w_ada": w_ada, "b_ada": b_ada, "g_pre_mix": g_pre_mix,
            "w_in": w_in, "attn_sink": attn_sink, "ssm_a_re": ssm_a_re, "ssm_a_im": ssm_a_im,
            "ssm_log_dt": ssm_log_dt, "ssm_b_re": ssm_b_re, "ssm_b_im": ssm_b_im,
            "ssm_c_re": ssm_c_re, "ssm_c_im": ssm_c_im, "ssm_d": ssm_d, "w_glu": w_glu,
            "b_glu": b_glu, "g_attn_out": g_attn_out, "g_ssm_out": g_ssm_out, "w_out": w_out,
            "g_post_mix": g_post_mix, "g_pre_ffn": g_pre_ffn, "w_router": w_router,
            "b_router": b_router, "w_gate_up": w_gate_up, "b_gate_up": b_gate_up,
            "w_down": w_down, "b_down": b_down, "g_post_ffn": g_post_ffn}


def reference(x, c, w_ada, b_ada, g_pre_mix, w_in, attn_sink, ssm_a_re, ssm_a_im, ssm_log_dt,
              ssm_b_re, ssm_b_im, ssm_c_re, ssm_c_im, ssm_d, w_glu, b_glu, g_attn_out, g_ssm_out,
              w_out, g_post_mix, g_pre_ffn, w_router, b_router, w_gate_up, b_gate_up, w_down,
              b_down, g_post_ffn):
    c_act = jax.nn.silu(c)
    for l in range(DEPTH):
        mods = c_act @ w_ada[l] + b_ada[l]
        sh1, sc1, gt1, sh2, sc2, gt2 = [m[:, None, :] for m in jnp.split(mods, 6, axis=-1)]
        h = rms_norm(x, g_pre_mix[l]) * (1.0 + sc1) + sh1
        y = hybrid_mixer(h, w_in[l], attn_sink[l], ssm_a_re[l], ssm_a_im[l], ssm_log_dt[l],
                         ssm_b_re[l], ssm_b_im[l], ssm_c_re[l], ssm_c_im[l], ssm_d[l],
                         w_glu[l], b_glu[l], g_attn_out[l], g_ssm_out[l], w_out[l])
        x = x + gt1 * rms_norm(y, g_post_mix[l])
        h = rms_norm(x, g_pre_ffn[l]) * (1.0 + sc2) + sh2
        y = moe_ffn(h, w_router[l], b_router[l], w_gate_up[l], b_gate_up[l], w_down[l], b_down[l])
        x = x + gt2 * rms_norm(y, g_post_ffn[l])
    return x
```

```cpp
#include <hip/hip_runtime.h>
#include <cstdio>
#include <cstdint>

#ifndef MK_N_LAUNCHES
#define MK_N_LAUNCHES 0
#endif

constexpr int BATCH = 4, SEQ = 4096, DM = 1024, NTOK = BATCH * SEQ;
constexpr int AW = 512, KVW = 128, SW = 512, INW = AW + 2 * KVW + SW;
constexpr int NQH = 8, NKVH = 2, HD = 64, WIN = 128;
constexpr int NG = 32, PST = 64, CH = 16;
constexpr int NE = 32, TOPK = 4, DFF = 1024;
constexpr int NMOD = 6 * DM;
constexpr float RMS_EPS = 1e-6f;
constexpr int COL_K = AW, COL_V = AW + KVW, COL_U = AW + 2 * KVW;

constexpr int NWAVES = 8, NTHR = NWAVES * 64;
constexpr int LDS_BYTES = 147456;
constexpr int MISC_OFF = 131072 + 320;

constexpr size_t MiB = 1u << 20;
constexpr size_t WS_CTL = 0, CTL_ZERO_BYTES = 1 * MiB;
constexpr size_t WS_MODS = 1 * MiB;
constexpr size_t WS_TOPI = 2 * MiB;
constexpr size_t WS_TOPG = 3 * MiB;
constexpr size_t WS_ELIST = 4 * MiB;
constexpr size_t WS_HBUF = 8 * MiB;
constexpr size_t WS_XMID = 72 * MiB;
constexpr size_t WS_PROJ = 136 * MiB;
constexpr size_t WS_ATT = 216 * MiB;
constexpr size_t WS_YSSM = 248 * MiB;
constexpr size_t WS_G = 312 * MiB;
constexpr size_t WS_GLUO = 344 * MiB;
constexpr size_t WS_YCAT = 376 * MiB;
constexpr size_t WS_YO = 440 * MiB;
constexpr size_t WS_ACT = 136 * MiB;
constexpr size_t WS_YROWS = 504 * MiB;
constexpr size_t WS_END = 760 * MiB;
static_assert(WS_ACT + (size_t)NTOK * 4 * 1024 * 4 <= WS_YO, "ACT overlay must not reach YO");

constexpr int CW_TMO = 0;
constexpr int CW_BAR = 4096;
constexpr int CW_ECNT = 16384;

#define LAS __attribute__((address_space(3)))
typedef float f32x4 __attribute__((ext_vector_type(4)));

#define XB_TMO      128
#define XB_XCNT(j)  (256  + 64 * (j))
#define XB_XSUB(j)  (1280 + 64 * (j))
#define XB_XGEN(j)  (2304 + 64 * (j))
#define XB_TOP      3328
#define XB_TOPGEN   3392
#define XCD_BAR_WORDS 3456
#define XB_SPIN_CAP (1u << 18)

__device__ __forceinline__ unsigned xb_ld(unsigned* p)              { return __hip_atomic_load(p, __ATOMIC_RELAXED, __HIP_MEMORY_SCOPE_AGENT); }
__device__ __forceinline__ unsigned xb_add(unsigned* p, unsigned v) { return __hip_atomic_fetch_add(p, v, __ATOMIC_RELAXED, __HIP_MEMORY_SCOPE_AGENT); }
__device__ __forceinline__ unsigned xb_xcc_id() { return (unsigned)__builtin_amdgcn_s_getreg((3 << 11) | 20) & 0xFu; }
#define XB_SPIN(cond, bar) do { unsigned _sp = 0; while (cond) { __builtin_amdgcn_s_sleep(1); \
    if ((++_sp & 255u) == 0u) { if (xb_ld(&(bar)[XB_TMO])) break; if (_sp > XB_SPIN_CAP) { atomicAdd(&(bar)[XB_TMO], 1u); break; } } } } while (0)

struct XcdBarrier { unsigned* bar; unsigned x; volatile LAS unsigned* st; };

__device__ __forceinline__ XcdBarrier xcd_barrier_post(unsigned* bar, volatile LAS unsigned* st) {
    XcdBarrier b; b.bar = bar; b.x = xb_xcc_id(); b.st = st;
    if (threadIdx.x == 0) (void)xb_add(&bar[XB_XCNT(b.x)], 1u);
    return b;
}
__device__ __forceinline__ void xcd_barrier_complete(unsigned* bar, unsigned x, unsigned& nloc, unsigned& nx) {
    const unsigned G = gridDim.x * gridDim.y * gridDim.z;
    unsigned sum, cnt, mine, sp = 0u;
    for (;;) {
        sum = 0u; cnt = 0u; mine = 0u;
#pragma unroll
        for (unsigned j = 0; j < 16; ++j) { const unsigned c = xb_ld(&bar[XB_XCNT(j)]); sum += c; cnt += (c > 0u) ? 1u : 0u; mine = (j == x) ? c : mine; }
        if (sum == G) break;
        __builtin_amdgcn_s_sleep(1);
        if ((++sp & 255u) == 0u) { if (xb_ld(&bar[XB_TMO])) break; if (sp > XB_SPIN_CAP) { atomicAdd(&bar[XB_TMO], 1u); break; } }
    }
    nloc = mine > 0u ? mine : 1u; nx = cnt > 0u ? cnt : 1u;
}
__device__ __forceinline__ void xcd_barrier(const XcdBarrier& b) {
    asm volatile("s_waitcnt vmcnt(0)" ::: "memory");
    __syncthreads();
    if (threadIdx.x == 0) {
        unsigned* bar = b.bar;
        __builtin_amdgcn_s_waitcnt(0);
        unsigned nloc = b.st[0], nx = b.st[1];
        if (nloc == 0u) { xcd_barrier_complete(bar, b.x, nloc, nx); b.st[0] = nloc; b.st[1] = nx; }
        const unsigned old = xb_add(&bar[XB_XSUB(b.x)], 1u);
        const unsigned gen = old / nloc;
        if (old + 1u == (gen + 1u) * nloc) {
            __builtin_amdgcn_fence(__ATOMIC_RELEASE, "agent");
            asm volatile("s_waitcnt vmcnt(0)" ::: "memory");
            const unsigned og = xb_add(&bar[XB_TOP], 1u);
            const unsigned tg = og / nx;
            if (og + 1u == (tg + 1u) * nx) xb_add(&bar[XB_TOPGEN], 1u);
            else XB_SPIN(xb_ld(&bar[XB_TOPGEN]) == tg, bar);
            __builtin_amdgcn_fence(__ATOMIC_ACQUIRE, "agent");
            xb_add(&bar[XB_XGEN(b.x)], 1u);
            asm volatile("s_waitcnt vmcnt(0)" ::: "memory");
        } else {
            XB_SPIN(xb_ld(&bar[XB_XGEN(b.x)]) == gen, bar);
            __builtin_amdgcn_fence(__ATOMIC_ACQUIRE, "agent");
            asm volatile("s_waitcnt vmcnt(0)" ::: "memory");
        }
    }
    __syncthreads();
}

struct Frame {
    unsigned char* lds;
    int tid, lane, wave, bid, G;
    const float* in[29];
    float* out;
    unsigned char* ws;
    unsigned* ctl;
};
enum { I_X = 0, I_C, I_WADA, I_BADA, I_GPRE, I_WIN, I_SINK, I_ARE, I_AIM, I_LOGDT, I_BRE, I_BIM, I_CRE, I_CIM, I_DSK, I_WGLU, I_BGLU,
       I_GATT, I_GSSM, I_WOUT, I_GPOST, I_GPREF, I_WR, I_BR, I_WGU, I_BGU, I_WD, I_BD, I_GPOSTF };

__device__ __forceinline__ float wave_sum(float v) {
#pragma unroll
    for (int o = 1; o < 64; o <<= 1) v += __shfl_xor(v, o);
    return v;
}
__device__ __forceinline__ float wave_max(float v) {
#pragma unroll
    for (int o = 1; o < 64; o <<= 1) v = fmaxf(v, __shfl_xor(v, o));
    return v;
}
__device__ __forceinline__ float sigmoidf_(float x) { return 1.0f / (1.0f + expf(-x)); }
__device__ __forceinline__ float gelu_tanh(float x) { const float u = 0.7978845608028654f * (x + 0.044715f * x * x * x); return 0.5f * x * (1.0f + tanhf(u)); }

__device__ __forceinline__ void row_load(const float* row, int lane, f32x4 (&v)[4]) {
#pragma unroll
    for (int j = 0; j < 4; ++j) v[j] = *(const f32x4*)(row + (j * 64 + lane) * 4);
}
__device__ __forceinline__ void row_store(float* row, int lane, const f32x4 (&v)[4]) {
#pragma unroll
    for (int j = 0; j < 4; ++j) *(f32x4*)(row + (j * 64 + lane) * 4) = v[j];
}
__device__ __forceinline__ float row_sumsq(const f32x4 (&v)[4]) {
    float s = 0.f;
#pragma unroll
    for (int j = 0; j < 4; ++j) s += v[j].x * v[j].x + v[j].y * v[j].y + v[j].z * v[j].z + v[j].w * v[j].w;
    return wave_sum(s);
}

template <int MODE>
__device__ __forceinline__ void naive_tile(Frame& F, const float* A, int lda, const int* list, int nvalid, int m0,
                                           const float* B, int ldb, int n0, int K, float* C, int ldc, const float* bias) {
    float* As = (float*)F.lds;
    float* Bs = As + 16 * 132;
    float* Bs2 = Bs + 16 * 68;
    const int tid = F.tid, tm = tid >> 4, tn = tid & 15;
    float acc[4][4], acc2[4][4];
#pragma unroll
    for (int i = 0; i < 4; ++i)
#pragma unroll
        for (int j = 0; j < 4; ++j) { acc[i][j] = 0.f; acc2[i][j] = 0.f; }
    const int ar = tid >> 2, ak = (tid & 3) * 4;
    const float* arow = nullptr;
    {
        const int r = m0 + ar;
        if (MODE == 0) arow = A + (size_t)r * lda;
        else if (r < nvalid) { const int a = list[r]; arow = A + (size_t)(MODE == 1 ? (a >> 2) : a) * lda; }
    }
    const int bk = (tid & 255) >> 4, bn = (tid & 15) * 4;
    for (int k0 = 0; k0 < K; k0 += 16) {
        f32x4 av = (f32x4){0.f, 0.f, 0.f, 0.f};
        if (arow) av = *(const f32x4*)(arow + k0 + ak);
        f32x4 bv = (f32x4){0.f, 0.f, 0.f, 0.f};
        if (tid < 256) bv = *(const f32x4*)(B + (size_t)(k0 + bk) * ldb + n0 + bn);
        else if (MODE == 1) bv = *(const f32x4*)(B + (size_t)(k0 + bk) * ldb + n0 + DFF + bn);
        __syncthreads();
        As[(ak + 0) * 132 + ar] = av.x; As[(ak + 1) * 132 + ar] = av.y; As[(ak + 2) * 132 + ar] = av.z; As[(ak + 3) * 132 + ar] = av.w;
        if (tid < 256) *(f32x4*)(Bs + bk * 68 + bn) = bv;
        else if (MODE == 1) *(f32x4*)(Bs2 + bk * 68 + bn) = bv;
        __syncthreads();
#pragma unroll
        for (int k = 0; k < 16; ++k) {
            const f32x4 a4 = *(const f32x4*)(As + k * 132 + tm * 4);
            const f32x4 b4 = *(const f32x4*)(Bs + k * 68 + tn * 4);
            const float a_[4] = {a4.x, a4.y, a4.z, a4.w}, b_[4] = {b4.x, b4.y, b4.z, b4.w};
#pragma unroll
            for (int i = 0; i < 4; ++i)
#pragma unroll
                for (int j = 0; j < 4; ++j) acc[i][j] += a_[i] * b_[j];
            if (MODE == 1) {
                const f32x4 c4 = *(const f32x4*)(Bs2 + k * 68 + tn * 4);
                const float c_[4] = {c4.x, c4.y, c4.z, c4.w};
#pragma unroll
                for (int i = 0; i < 4; ++i)
#pragma unroll
                    for (int j = 0; j < 4; ++j) acc2[i][j] += a_[i] * c_[j];
            }
        }
    }
#pragma unroll
    for (int i = 0; i < 4; ++i) {
        const int r = m0 + tm * 4 + i;
        if (MODE != 0 && r >= nvalid) continue;
        const size_t orow = (MODE == 0) ? (size_t)r : (size_t)list[r];
        f32x4 o;
        float ov[4];
#pragma unroll
        for (int j = 0; j < 4; ++j) {
            const int n = n0 + tn * 4 + j;
            if (MODE == 0) ov[j] = acc[i][j];
            else if (MODE == 1) {
                float glu = acc[i][j] + bias[n], lin = acc2[i][j] + bias[n + DFF];
                glu = fminf(glu, 7.0f); lin = fminf(fmaxf(lin, -7.0f), 7.0f);
                ov[j] = glu * sigmoidf_(1.702f * glu) * (lin + 1.0f);
            } else ov[j] = acc[i][j] + bias[n];
        }
        o.x = ov[0]; o.y = ov[1]; o.z = ov[2]; o.w = ov[3];
        *(f32x4*)(C + orow * ldc + n0 + tn * 4) = o;
    }
    __syncthreads();
}

__device__ __forceinline__ void naive_gemm_plain(Frame& F, const float* A, int lda, const float* B, int ldb, float* C, int ldc, int M, int N, int K) {
    const int nM = M / 128, nN = N / 64;
    for (int t = F.bid; t < nM * nN; t += F.G) {
        const int tmi = t / nN, tni = t % nN;
        naive_tile<0>(F, A, lda, nullptr, 0, tmi * 128, B, ldb, tni * 64, K, C, ldc, nullptr);
    }
}

__device__ __forceinline__ void ph_mods(Frame& F) {
    float* sc = (float*)F.lds;
    float* red = sc + 4096;
    float* mods = (float*)(F.ws + WS_MODS);
    const float* c = F.in[I_C]; const float* w = F.in[I_WADA]; const float* bb = F.in[I_BADA];
    for (int cg = F.bid; cg < NMOD / 256; cg += F.G) {
        __syncthreads();
        for (int i = F.tid; i < 4096; i += NTHR) { const float v = c[i]; sc[i] = v / (1.0f + expf(-v)); }
        __syncthreads();
        f32x4 acc[4];
#pragma unroll
        for (int b = 0; b < 4; ++b) acc[b] = (f32x4){0.f, 0.f, 0.f, 0.f};
        const int kb = F.wave * 128;
        for (int k = kb; k < kb + 128; ++k) {
            const f32x4 wv = *(const f32x4*)(w + (size_t)k * NMOD + cg * 256 + F.lane * 4);
#pragma unroll
            for (int b = 0; b < 4; ++b) acc[b] += sc[b * 1024 + k] * wv;
        }
#pragma unroll
        for (int b = 0; b < 4; ++b) *(f32x4*)(red + ((F.wave * 4 + b) * 256 + F.lane * 4)) = acc[b];
        __syncthreads();
        for (int i = F.tid; i < 1024; i += NTHR) {
            const int b = i >> 8, col = i & 255;
            float s = 0.f;
#pragma unroll
            for (int wv = 0; wv < 8; ++wv) s += red[(wv * 4 + b) * 256 + col];
            mods[b * NMOD + cg * 256 + col] = s + bb[cg * 256 + col];
        }
    }
    __syncthreads();
}

__device__ __forceinline__ void ph_h1(Frame& F) {
    const float* mods = (const float*)(F.ws + WS_MODS);
    float* H = (float*)(F.ws + WS_HBUF);
    const float* g = F.in[I_GPRE];
    for (int row = F.bid * NWAVES + F.wave; row < NTOK; row += F.G * NWAVES) {
        const int b = row / SEQ;
        f32x4 v[4]; row_load(F.in[I_X] + (size_t)row * DM, F.lane, v);
        const float rstd = rsqrtf(row_sumsq(v) * (1.0f / DM) + RMS_EPS);
#pragma unroll
        for (int j = 0; j < 4; ++j) {
            const int c0 = (j * 64 + F.lane) * 4;
            const f32x4 gg = *(const f32x4*)(g + c0), sh = *(const f32x4*)(mods + b * NMOD + c0), scv = *(const f32x4*)(mods + b * NMOD + DM + c0);
            v[j] = v[j] * rstd * gg * (1.0f + scv) + sh;
        }
        row_store(H + (size_t)row * DM, F.lane, v);
    }
}

__device__ __forceinline__ void ph_rope(Frame& F) {
    float* P = (float*)(F.ws + WS_PROJ);
    const int total = NTOK * 10 * 32;
    for (int idx = F.bid * NTHR + F.tid; idx < total; idx += F.G * NTHR) {
        const int i = idx & 31, hh = (idx >> 5) % 10, tok = idx / 320;
        const int cb = hh < 8 ? hh * 64 : COL_K + (hh - 8) * 64;
        const int pos = tok % SEQ;
        const float inv = powf(10000.0f, -(float)i * (2.0f / 64.0f));
        const float ang = (float)pos * inv;
        const float cs = cosf(ang), sn = sinf(ang);
        float* p = P + (size_t)tok * INW + cb + i;
        const float t1 = p[0], t2 = p[32];
        p[0] = t1 * cs - t2 * sn; p[32] = t2 * cs + t1 * sn;
    }
}

__device__ __forceinline__ void ph_attn(Frame& F) {
    const float* P = (const float*)(F.ws + WS_PROJ);
    float* O = (float*)(F.ws + WS_ATT);
    const float* sink = F.in[I_SINK];
    for (int it = F.bid * NWAVES + F.wave; it < NTOK * NQH; it += F.G * NWAVES) {
        const int qh = it & 7, tok = it >> 3, b = tok / SEQ, t = tok % SEQ, kvh = qh >> 2;
        const float q = P[(size_t)tok * INW + qh * 64 + F.lane] * 0.125f;
        float m = sink[qh], l = 1.0f, o = 0.0f;
        const int j0 = t - WIN < 0 ? 0 : t - WIN, j1 = t + WIN > SEQ - 1 ? SEQ - 1 : t + WIN;
        for (int j = j0; j <= j1; ++j) {
            const float* kr = P + (size_t)(b * SEQ + j) * INW;
            const float s = wave_sum(q * kr[COL_K + kvh * 64 + F.lane]);
            const float mn = fmaxf(m, s), corr = expf(m - mn), p = expf(s - mn);
            l = l * corr + p; o = o * corr + p * kr[COL_V + kvh * 64 + F.lane]; m = mn;
        }
        O[(size_t)tok * AW + qh * 64 + F.lane] = o / l;
    }
}

__device__ __forceinline__ void ph_s5(Frame& F) {
    const float* P = (const float*)(F.ws + WS_PROJ);
    float* Y = (float*)(F.ws + WS_YSSM);
    float* us = (float*)F.lds;
    float* ys = us + 1024;
    if (F.wave != 0) return;
    const int lane = F.lane;
    for (int item = F.bid; item < BATCH * NG * 2; item += F.G) {
        const int dir = item & 1, g = (item >> 1) % NG, b = item / (2 * NG);
        const int pi = (dir * NG + g) * PST + lane;
        const float a_re = F.in[I_ARE][pi], a_im = F.in[I_AIM][pi];
        const float dt = expf(F.in[I_LOGDT][dir * NG + g]);
        const float lr = a_re * dt, li = a_im * dt, mag = expf(lr);
        const float abr = mag * cosf(li), abi = mag * sinf(li);
        const float den = a_re * a_re + a_im * a_im, nr = abr - 1.0f, ni = abi;
        const float f_r = (nr * a_re + ni * a_im) / den, f_i = (ni * a_re - nr * a_im) / den;
        float bbr[16], bbi[16], cr[16], ci[16];
#pragma unroll
        for (int h = 0; h < 16; ++h) {
            const float br = F.in[I_BRE][(size_t)pi * CH + h], bi = F.in[I_BIM][(size_t)pi * CH + h];
            bbr[h] = f_r * br - f_i * bi; bbi[h] = f_r * bi + f_i * br;
            cr[h] = F.in[I_CRE][((size_t)(dir * NG + g) * CH + h) * PST + lane];
            ci[h] = F.in[I_CIM][((size_t)(dir * NG + g) * CH + h) * PST + lane];
        }
        float sr = 0.f, si = 0.f;
        for (int c = 0; c < SEQ / 64; ++c) {
            const int t0 = dir ? (SEQ - 64 - c * 64) : c * 64;
            {
                const float* ur = P + (size_t)(b * SEQ + t0 + lane) * INW + COL_U + g * CH;
#pragma unroll
                for (int q = 0; q < 4; ++q) *(f32x4*)(us + lane * 16 + q * 4) = *(const f32x4*)(ur + q * 4);
            }
            __builtin_amdgcn_s_waitcnt(0);
            __builtin_amdgcn_wave_barrier();
            for (int s = 0; s < 64; ++s) {
                const int tt = dir ? 63 - s : s;
                float u[16];
#pragma unroll
                for (int q = 0; q < 4; ++q) { const f32x4 t4 = *(const f32x4*)(us + tt * 16 + q * 4); u[q * 4] = t4.x; u[q * 4 + 1] = t4.y; u[q * 4 + 2] = t4.z; u[q * 4 + 3] = t4.w; }
                float bur = 0.f, bui = 0.f;
#pragma unroll
                for (int h = 0; h < 16; ++h) { bur += bbr[h] * u[h]; bui += bbi[h] * u[h]; }
                const float nsr = abr * sr - abi * si + bur, nsi = abr * si + abi * sr + bui;
                sr = nsr; si = nsi;
                float yv = 0.f;
#pragma unroll
                for (int h = 0; h < 16; ++h) { const float v = wave_sum(cr[h] * sr - ci[h] * si); yv = (lane == h) ? v : yv; }
                if (lane < 16) ys[tt * 16 + lane] = yv;
            }
            __builtin_amdgcn_s_waitcnt(0);
            __builtin_amdgcn_wave_barrier();
            {
                float* yr = Y + ((size_t)dir * NTOK + (size_t)(b * SEQ + t0 + lane)) * SW + g * CH;
#pragma unroll
                for (int q = 0; q < 4; ++q) *(f32x4*)(yr + q * 4) = *(const f32x4*)(ys + lane * 16 + q * 4);
            }
            __builtin_amdgcn_s_waitcnt(0);
            __builtin_amdgcn_wave_barrier();
        }
    }
}

__device__ __forceinline__ void ph_gelu(Frame& F) {
    const float* P = (const float*)(F.ws + WS_PROJ);
    const float* Y = (const float*)(F.ws + WS_YSSM);
    float* Gb = (float*)(F.ws + WS_G);
    const float* dsk = F.in[I_DSK];
    const int total = NTOK * SW / 4;
    for (int idx = F.bid * NTHR + F.tid; idx < total; idx += F.G * NTHR) {
        const int tok = idx / (SW / 4), c = (idx % (SW / 4)) * 4;
        const f32x4 u = *(const f32x4*)(P + (size_t)tok * INW + COL_U + c);
        const f32x4 y0 = *(const f32x4*)(Y + (size_t)tok * SW + c), y1 = *(const f32x4*)(Y + ((size_t)NTOK + tok) * SW + c);
        const f32x4 d = *(const f32x4*)(dsk + c);
        f32x4 v = d * u + y0 + y1;
        v.x = gelu_tanh(v.x); v.y = gelu_tanh(v.y); v.z = gelu_tanh(v.z); v.w = gelu_tanh(v.w);
        *(f32x4*)(Gb + (size_t)tok * SW + c) = v;
    }
}

__device__ __forceinline__ void ph_cat(Frame& F) {
    const float* Gb = (const float*)(F.ws + WS_G); const float* GL = (const float*)(F.ws + WS_GLUO);
    const float* AT = (const float*)(F.ws + WS_ATT); float* YC = (float*)(F.ws + WS_YCAT);
    for (int row = F.bid * NWAVES + F.wave; row < NTOK; row += F.G * NWAVES) {
        f32x4 a[2], s[2];
        float sa = 0.f, ss = 0.f;
#pragma unroll
        for (int j = 0; j < 2; ++j) {
            const int c0 = (j * 64 + F.lane) * 4;
            a[j] = *(const f32x4*)(AT + (size_t)row * AW + c0);
            const f32x4 gv = *(const f32x4*)(Gb + (size_t)row * SW + c0), gl = *(const f32x4*)(GL + (size_t)row * SW + c0), bg = *(const f32x4*)(F.in[I_BGLU] + c0);
            f32x4 z = gl + bg;
            z.x = sigmoidf_(z.x); z.y = sigmoidf_(z.y); z.z = sigmoidf_(z.z); z.w = sigmoidf_(z.w);
            s[j] = gv * z;
            sa += a[j].x * a[j].x + a[j].y * a[j].y + a[j].z * a[j].z + a[j].w * a[j].w;
            ss += s[j].x * s[j].x + s[j].y * s[j].y + s[j].z * s[j].z + s[j].w * s[j].w;
        }
        const float ra = rsqrtf(wave_sum(sa) * (1.0f / AW) + RMS_EPS), rs = rsqrtf(wave_sum(ss) * (1.0f / SW) + RMS_EPS);
#pragma unroll
        for (int j = 0; j < 2; ++j) {
            const int c0 = (j * 64 + F.lane) * 4;
            *(f32x4*)(YC + (size_t)row * DM + c0) = a[j] * ra * *(const f32x4*)(F.in[I_GATT] + c0);
            *(f32x4*)(YC + (size_t)row * DM + AW + c0) = s[j] * rs * *(const f32x4*)(F.in[I_GSSM] + c0);
        }
    }
}

__device__ __forceinline__ void ph_mid(Frame& F) {
    const float* mods = (const float*)(F.ws + WS_MODS);
    const float* YO = (const float*)(F.ws + WS_YO);
    float* XM = (float*)(F.ws + WS_XMID); float* H = (float*)(F.ws + WS_HBUF);
    int* topi = (int*)(F.ws + WS_TOPI); float* topg = (float*)(F.ws + WS_TOPG); int* elist = (int*)(F.ws + WS_ELIST);
    const float* wr = F.in[I_WR];
    for (int row = F.bid * NWAVES + F.wave; row < NTOK; row += F.G * NWAVES) {
        const int b = row / SEQ;
        f32x4 y[4], x[4]; row_load(YO + (size_t)row * DM, F.lane, y); row_load(F.in[I_X] + (size_t)row * DM, F.lane, x);
        const float ry = rsqrtf(row_sumsq(y) * (1.0f / DM) + RMS_EPS);
#pragma unroll
        for (int j = 0; j < 4; ++j) {
            const int c0 = (j * 64 + F.lane) * 4;
            x[j] = x[j] + *(const f32x4*)(mods + b * NMOD + 2 * DM + c0) * (y[j] * ry * *(const f32x4*)(F.in[I_GPOST] + c0));
        }
        row_store(XM + (size_t)row * DM, F.lane, x);
        const float rx = rsqrtf(row_sumsq(x) * (1.0f / DM) + RMS_EPS);
        f32x4 h[4];
#pragma unroll
        for (int j = 0; j < 4; ++j) {
            const int c0 = (j * 64 + F.lane) * 4;
            h[j] = x[j] * rx * *(const f32x4*)(F.in[I_GPREF] + c0) * (1.0f + *(const f32x4*)(mods + b * NMOD + 4 * DM + c0)) + *(const f32x4*)(mods + b * NMOD + 3 * DM + c0);
        }
        row_store(H + (size_t)row * DM, F.lane, h);
        float lg[32];
#pragma unroll
        for (int e = 0; e < 32; ++e) lg[e] = 0.f;
#pragma unroll
        for (int j = 0; j < 4; ++j) {
            const float hv[4] = {h[j].x, h[j].y, h[j].z, h[j].w};
#pragma unroll
            for (int q = 0; q < 4; ++q) {
                const float* wrow = wr + (size_t)((j * 64 + F.lane) * 4 + q) * NE;
#pragma unroll
                for (int e4 = 0; e4 < 8; ++e4) { const f32x4 w4 = *(const f32x4*)(wrow + e4 * 4);
                    lg[e4 * 4] += hv[q] * w4.x; lg[e4 * 4 + 1] += hv[q] * w4.y; lg[e4 * 4 + 2] += hv[q] * w4.z; lg[e4 * 4 + 3] += hv[q] * w4.w; }
            }
        }
        float mine = -3.0e38f;
#pragma unroll
        for (int e = 0; e < 32; ++e) { const float s = wave_sum(lg[e]); mine = (F.lane == e) ? s : mine; }
        if (F.lane < 32) mine += F.in[I_BR][F.lane];
        float tv[4]; int ti[4];
#pragma unroll
        for (int k = 0; k < 4; ++k) {
            const float mx = wave_max(mine);
            const unsigned long long bal = __ballot(mine == mx);
            const int idx = __ffsll((long long)bal) - 1;
            tv[k] = mx; ti[k] = idx;
            if (F.lane == idx) mine = -3.0e38f;
        }
        const float w1 = expf(tv[1] - tv[0]), w2 = expf(tv[2] - tv[0]), w3 = expf(tv[3] - tv[0]);
        const float inv = 1.0f / (1.0f + w1 + w2 + w3);
        const float gk[4] = {inv, w1 * inv, w2 * inv, w3 * inv};
#pragma unroll
        for (int k = 0; k < 4; ++k) {
            if (F.lane == k) {
                topi[row * 4 + k] = ti[k]; topg[row * 4 + k] = gk[k];
                const unsigned pos = atomicAdd(F.ctl + CW_ECNT + 64 * ti[k], 1u);
                elist[(size_t)ti[k] * NTOK + pos] = row * 4 + k;
            }
        }
    }
}

template <int MODE>
__device__ __forceinline__ void ph_moe(Frame& F) {
    const int* elist = (const int*)(F.ws + WS_ELIST);
    const float* H = (const float*)(F.ws + WS_HBUF);
    float* ACT = (float*)(F.ws + WS_ACT); float* YR = (float*)(F.ws + WS_YROWS);
    constexpr int NT = 1024 / 64, MT = NTOK / 128;
    for (int t = F.bid; t < NE * MT * NT; t += F.G) {
        const int nt = t % NT, mt = (t / NT) % MT, e = t / (NT * MT);
        const int cnt = (int)__hip_atomic_load(F.ctl + CW_ECNT + 64 * e, __ATOMIC_RELAXED, __HIP_MEMORY_SCOPE_AGENT);
        if (mt * 128 >= cnt) continue;
        if (MODE == 1) naive_tile<1>(F, H, DM, elist + (size_t)e * NTOK, cnt, mt * 128, F.in[I_WGU] + (size_t)e * DM * 2 * DFF, 2 * DFF, nt * 64, DM, ACT, DFF, F.in[I_BGU] + (size_t)e * 2 * DFF);
        else naive_tile<2>(F, ACT, DFF, elist + (size_t)e * NTOK, cnt, mt * 128, F.in[I_WD] + (size_t)e * DFF * DM, DM, nt * 64, DFF, YR, DM, F.in[I_BD] + (size_t)e * DM);
    }
}

__device__ __forceinline__ void ph_final(Frame& F) {
    const float* mods = (const float*)(F.ws + WS_MODS);
    const float* XM = (const float*)(F.ws + WS_XMID); const float* YR = (const float*)(F.ws + WS_YROWS);
    const float* topg = (const float*)(F.ws + WS_TOPG);
    for (int row = F.bid * NWAVES + F.wave; row < NTOK; row += F.G * NWAVES) {
        const int b = row / SEQ;
        f32x4 y[4];
#pragma unroll
        for (int j = 0; j < 4; ++j) y[j] = (f32x4){0.f, 0.f, 0.f, 0.f};
#pragma unroll
        for (int k = 0; k < 4; ++k) {
            const float gk = topg[row * 4 + k];
            f32x4 v[4]; row_load(YR + (size_t)(row * 4 + k) * DM, F.lane, v);
#pragma unroll
            for (int j = 0; j < 4; ++j) y[j] += gk * v[j];
        }
        const float ry = rsqrtf(row_sumsq(y) * (1.0f / DM) + RMS_EPS);
        f32x4 x[4]; row_load(XM + (size_t)row * DM, F.lane, x);
#pragma unroll
        for (int j = 0; j < 4; ++j) {
            const int c0 = (j * 64 + F.lane) * 4;
            x[j] = x[j] + *(const f32x4*)(mods + b * NMOD + 5 * DM + c0) * (y[j] * ry * *(const f32x4*)(F.in[I_GPOSTF] + c0));
        }
        row_store(F.out + (size_t)row * DM, F.lane, x);
    }
}

constexpr int NPH = 13;
struct Args { const float* in[29]; float* out; unsigned char* ws; int ph_lo, ph_hi; };

__global__ void __launch_bounds__(NTHR, 2) fwd_kernel(Args args) {
    extern __shared__ __attribute__((aligned(16))) unsigned char lds[];
    Frame F;
    F.lds = lds;
    F.tid = threadIdx.x; F.lane = F.tid & 63; F.wave = __builtin_amdgcn_readfirstlane(F.tid >> 6);
    F.bid = blockIdx.x; F.G = gridDim.x;
#pragma unroll
    for (int i = 0; i < 29; ++i) F.in[i] = args.in[i];
    F.out = args.out; F.ws = args.ws; F.ctl = (unsigned*)(args.ws + WS_CTL);
    volatile LAS unsigned* MISC = (volatile LAS unsigned*)((LAS unsigned char*)lds + MISC_OFF);
    if (F.tid < 32) MISC[F.tid] = 0u;
    __syncthreads();
    XcdBarrier bar; bar.bar = F.ctl + CW_BAR; bar.x = 0; bar.st = nullptr;
    if (MK_N_LAUNCHES == 1) bar = xcd_barrier_post(F.ctl + CW_BAR, MISC + 8);
    const int lo = args.ph_lo, hi = args.ph_hi;
#define IN(k) (lo <= (k) && (k) < hi)
#define SEAM(k) do { if (MK_N_LAUNCHES == 1 && IN(k) && IN((k) + 1)) xcd_barrier(bar); } while (0)
    float* HB = (float*)(F.ws + WS_HBUF); float* PJ = (float*)(F.ws + WS_PROJ);
    if (IN(0)) { ph_mods(F); } SEAM(0);
    if (IN(1)) { ph_h1(F); } SEAM(1);
    if (IN(2)) { naive_gemm_plain(F, HB, DM, F.in[I_WIN], INW, PJ, INW, NTOK, INW, DM); } SEAM(2);
    if (IN(3)) { ph_rope(F); } SEAM(3);
    if (IN(4)) { ph_attn(F); ph_s5(F); } SEAM(4);
    if (IN(5)) { ph_gelu(F); } SEAM(5);
    if (IN(6)) { naive_gemm_plain(F, (const float*)(F.ws + WS_G), SW, F.in[I_WGLU], SW, (float*)(F.ws + WS_GLUO), SW, NTOK, SW, SW); } SEAM(6);
    if (IN(7)) { ph_cat(F); } SEAM(7);
    if (IN(8)) { naive_gemm_plain(F, (const float*)(F.ws + WS_YCAT), DM, F.in[I_WOUT], DM, (float*)(F.ws + WS_YO), DM, NTOK, DM, DM); } SEAM(8);
    if (IN(9)) { ph_mid(F); } SEAM(9);
    if (IN(10)) { ph_moe<1>(F); } SEAM(10);
    if (IN(11)) { ph_moe<2>(F); } SEAM(11);
    if (IN(12)) { ph_final(F); }
#undef IN
#undef SEAM
}

extern "C" void kernel_launch(void* const* d_in, const int* in_sizes, int n_in, void* d_out, int out_size, void* d_ws, size_t ws_size, hipStream_t stream) {
    static int grid = 0;
    if (grid == 0) {
        if (n_in != 29 || ws_size < WS_END) { fprintf(stderr, "kernel_launch: unexpected n_in %d / ws %zu\n", n_in, ws_size); grid = -1; return; }
        int dev = 0, cus = 0, per_cu = 0;
        if (hipGetDevice(&dev) != hipSuccess || hipDeviceGetAttribute(&cus, hipDeviceAttributeMultiprocessorCount, dev) != hipSuccess) { grid = -1; return; }
        if (hipFuncSetAttribute((const void*)fwd_kernel, hipFuncAttributeMaxDynamicSharedMemorySize, LDS_BYTES) != hipSuccess) { fprintf(stderr, "kernel_launch: hipFuncSetAttribute failed\n"); grid = -1; return; }
        if (hipOccupancyMaxActiveBlocksPerMultiprocessor(&per_cu, (const void*)fwd_kernel, NTHR, LDS_BYTES) != hipSuccess || per_cu < 1)
            fprintf(stderr, "kernel_launch: occupancy query reports %d\n", per_cu);
        (void)hipGetLastError();
        grid = cus;
    }
    if (grid < 0) return;
    (void)hipMemsetAsync((char*)d_ws + WS_CTL, 0, CTL_ZERO_BYTES, stream);
    Args a{};
    for (int i = 0; i < 29; ++i) a.in[i] = (const float*)d_in[i];
    a.out = (float*)d_out; a.ws = (unsigned char*)d_ws;
    if (MK_N_LAUNCHES == 1) {
        a.ph_lo = 0; a.ph_hi = NPH;
        hipLaunchKernelGGL(fwd_kernel, dim3(grid), dim3(NTHR), LDS_BYTES, stream, a);
    } else {
        for (int p = 0; p < NPH; ++p) {
            a.ph_lo = p; a.ph_hi = p + 1;
            hipLaunchKernelGGL(fwd_kernel, dim3(grid), dim3(NTHR), LDS_BYTES, stream, a);
        }
    }
}
```

```cpp
#include <hip/hip_runtime.h>
#include <cstdio>
#include <cstdint>

#ifndef MK_N_LAUNCHES
#define MK_N_LAUNCHES 1
#endif

constexpr int BATCH = 4, SEQ = 4096, DM = 1024, NTOK = BATCH * SEQ;
constexpr int AW = 512, KVW = 128, SW = 512, INW = AW + 2 * KVW + SW;
constexpr int NQH = 8, NKVH = 2, HD = 64, WIN = 128;
constexpr int NG = 32, PST = 64, CH = 16;
constexpr int NE = 32, TOPK = 4, DFF = 1024;
constexpr int NMOD = 6 * DM;
constexpr float RMS_EPS = 1e-6f;
constexpr int COL_K = AW, COL_V = AW + KVW, COL_U = AW + 2 * KVW;

constexpr int NWAVES = 8, NTHR = NWAVES * 64;
constexpr int LDS_BYTES = 147456;
constexpr int MISC_OFF = 131072 + 320;

constexpr size_t MiB = 1u << 20;
constexpr size_t WS_CTL = 0, CTL_ZERO_BYTES = 1 * MiB;
constexpr size_t WS_MODS = 1 * MiB;
constexpr size_t WS_TOPI = 2 * MiB;
constexpr size_t WS_TOPG = 3 * MiB;
constexpr size_t WS_ELIST = 4 * MiB;
constexpr size_t WS_HBUF = 8 * MiB;
constexpr size_t WS_XMID = 72 * MiB;
constexpr size_t WS_PROJ = 136 * MiB;
constexpr size_t WS_ATT = 216 * MiB;
constexpr size_t WS_YSSM = 248 * MiB;
constexpr size_t WS_G = 312 * MiB;
constexpr size_t WS_GLUO = 344 * MiB;
constexpr size_t WS_YCAT = 376 * MiB;
constexpr size_t WS_YO = 440 * MiB;
constexpr size_t WS_ACT = 136 * MiB;
constexpr size_t WS_YROWS = 504 * MiB;
constexpr size_t WS_END = 760 * MiB;
static_assert(WS_ACT + (size_t)NTOK * 4 * 1024 * 4 <= WS_YO, "ACT overlay must not reach YO");

constexpr int CW_TMO = 0;
constexpr int CW_BAR = 4096;
constexpr int CW_ECNT = 16384;

#define LAS __attribute__((address_space(3)))
typedef float f32x4 __attribute__((ext_vector_type(4)));

#define XB_TMO      128
#define XB_XCNT(j)  (256  + 64 * (j))
#define XB_XSUB(j)  (1280 + 64 * (j))
#define XB_XGEN(j)  (2304 + 64 * (j))
#define XB_TOP      3328
#define XB_TOPGEN   3392
#define XCD_BAR_WORDS 3456
#define XB_SPIN_CAP (1u << 18)

__device__ __forceinline__ unsigned xb_ld(unsigned* p)              { return __hip_atomic_load(p, __ATOMIC_RELAXED, __HIP_MEMORY_SCOPE_AGENT); }
__device__ __forceinline__ unsigned xb_add(unsigned* p, unsigned v) { return __hip_atomic_fetch_add(p, v, __ATOMIC_RELAXED, __HIP_MEMORY_SCOPE_AGENT); }
__device__ __forceinline__ unsigned xb_xcc_id() { return (unsigned)__builtin_amdgcn_s_getreg((3 << 11) | 20) & 0xFu; }
#define XB_SPIN(cond, bar) do { unsigned _sp = 0; while (cond) { __builtin_amdgcn_s_sleep(1); \
    if ((++_sp & 255u) == 0u) { if (xb_ld(&(bar)[XB_TMO])) break; if (_sp > XB_SPIN_CAP) { atomicAdd(&(bar)[XB_TMO], 1u); break; } } } } while (0)

struct XcdBarrier { unsigned* bar; unsigned x; volatile LAS unsigned* st; };

__device__ __forceinline__ XcdBarrier xcd_barrier_post(unsigned* bar, volatile LAS unsigned* st) {
    XcdBarrier b; b.bar = bar; b.x = xb_xcc_id(); b.st = st;
    if (threadIdx.x == 0) (void)xb_add(&bar[XB_XCNT(b.x)], 1u);
    return b;
}
__device__ __forceinline__ void xcd_barrier_complete(unsigned* bar, unsigned x, unsigned& nloc, unsigned& nx) {
    const unsigned G = gridDim.x * gridDim.y * gridDim.z;
    unsigned sum, cnt, mine, sp = 0u;
    for (;;) {
        sum = 0u; cnt = 0u; mine = 0u;
#pragma unroll
        for (unsigned j = 0; j < 16; ++j) { const unsigned c = xb_ld(&bar[XB_XCNT(j)]); sum += c; cnt += (c > 0u) ? 1u : 0u; mine = (j == x) ? c : mine; }
        if (sum == G) break;
        __builtin_amdgcn_s_sleep(1);
        if ((++sp & 255u) == 0u) { if (xb_ld(&bar[XB_TMO])) break; if (sp > XB_SPIN_CAP) { atomicAdd(&bar[XB_TMO], 1u); break; } }
    }
    nloc = mine > 0u ? mine : 1u; nx = cnt > 0u ? cnt : 1u;
}
__device__ __forceinline__ void xcd_barrier(const XcdBarrier& b) {
    asm volatile("s_waitcnt vmcnt(0)" ::: "memory");
    __syncthreads();
    if (threadIdx.x == 0) {
        unsigned* bar = b.bar;
        __builtin_amdgcn_s_waitcnt(0);
        unsigned nloc = b.st[0], nx = b.st[1];
        if (nloc == 0u) { xcd_barrier_complete(bar, b.x, nloc, nx); b.st[0] = nloc; b.st[1] = nx; }
        const unsigned old = xb_add(&bar[XB_XSUB(b.x)], 1u);
        const unsigned gen = old / nloc;
        if (old + 1u == (gen + 1u) * nloc) {
            __builtin_amdgcn_fence(__ATOMIC_RELEASE, "agent");
            asm volatile("s_waitcnt vmcnt(0)" ::: "memory");
            const unsigned og = xb_add(&bar[XB_TOP], 1u);
            const unsigned tg = og / nx;
            if (og + 1u == (tg + 1u) * nx) xb_add(&bar[XB_TOPGEN], 1u);
            else XB_SPIN(xb_ld(&bar[XB_TOPGEN]) == tg, bar);
            __builtin_amdgcn_fence(__ATOMIC_ACQUIRE, "agent");
            xb_add(&bar[XB_XGEN(b.x)], 1u);
            asm volatile("s_waitcnt vmcnt(0)" ::: "memory");
        } else {
            XB_SPIN(xb_ld(&bar[XB_XGEN(b.x)]) == gen, bar);
            __builtin_amdgcn_fence(__ATOMIC_ACQUIRE, "agent");
            asm volatile("s_waitcnt vmcnt(0)" ::: "memory");
        }
    }
    __syncthreads();
}

struct Frame {
    unsigned char* lds;
    int tid, lane, wave, bid, G;
    const float* in[29];
    float* out;
    unsigned char* ws;
    unsigned* ctl;
};
enum { I_X = 0, I_C, I_WADA, I_BADA, I_GPRE, I_WIN, I_SINK, I_ARE, I_AIM, I_LOGDT, I_BRE, I_BIM, I_CRE, I_CIM, I_DSK, I_WGLU, I_BGLU,
       I_GATT, I_GSSM, I_WOUT, I_GPOST, I_GPREF, I_WR, I_BR, I_WGU, I_BGU, I_WD, I_BD, I_GPOSTF };

__device__ __forceinline__ float wave_sum(float v) {
#pragma unroll
    for (int o = 1; o < 64; o <<= 1) v += __shfl_xor(v, o);
    return v;
}
__device__ __forceinline__ float wave_max(float v) {
#pragma unroll
    for (int o = 1; o < 64; o <<= 1) v = fmaxf(v, __shfl_xor(v, o));
    return v;
}
__device__ __forceinline__ float sigmoidf_(float x) { return 1.0f / (1.0f + expf(-x)); }
__device__ __forceinline__ float gelu_tanh(float x) { const float u = 0.7978845608028654f * (x + 0.044715f * x * x * x); return 0.5f * x * (1.0f + tanhf(u)); }

__device__ __forceinline__ void row_load(const float* row, int lane, f32x4 (&v)[4]) {
#pragma unroll
    for (int j = 0; j < 4; ++j) v[j] = *(const f32x4*)(row + (j * 64 + lane) * 4);
}
__device__ __forceinline__ void row_store(float* row, int lane, const f32x4 (&v)[4]) {
#pragma unroll
    for (int j = 0; j < 4; ++j) *(f32x4*)(row + (j * 64 + lane) * 4) = v[j];
}
__device__ __forceinline__ float row_sumsq(const f32x4 (&v)[4]) {
    float s = 0.f;
#pragma unroll
    for (int j = 0; j < 4; ++j) s += v[j].x * v[j].x + v[j].y * v[j].y + v[j].z * v[j].z + v[j].w * v[j].w;
    return wave_sum(s);
}

template <int MODE>
__device__ __forceinline__ void naive_tile(Frame& F, const float* A, int lda, const int* list, int nvalid, int m0,
                                           const float* B, int ldb, int n0, int K, float* C, int ldc, const float* bias) {
    float* As = (float*)F.lds;
    float* Bs = As + 16 * 132;
    float* Bs2 = Bs + 16 * 68;
    const int tid = F.tid, tm = tid >> 4, tn = tid & 15;
    float acc[4][4], acc2[4][4];
#pragma unroll
    for (int i = 0; i < 4; ++i)
#pragma unroll
        for (int j = 0; j < 4; ++j) { acc[i][j] = 0.f; acc2[i][j] = 0.f; }
    const int ar = tid >> 2, ak = (tid & 3) * 4;
    const float* arow = nullptr;
    {
        const int r = m0 + ar;
        if (MODE == 0) arow = A + (size_t)r * lda;
        else if (r < nvalid) { const int a = list[r]; arow = A + (size_t)(MODE == 1 ? (a >> 2) : a) * lda; }
    }
    const int bk = (tid & 255) >> 4, bn = (tid & 15) * 4;
    for (int k0 = 0; k0 < K; k0 += 16) {
        f32x4 av = (f32x4){0.f, 0.f, 0.f, 0.f};
        if (arow) av = *(const f32x4*)(arow + k0 + ak);
        f32x4 bv = (f32x4){0.f, 0.f, 0.f, 0.f};
        if (tid < 256) bv = *(const f32x4*)(B + (size_t)(k0 + bk) * ldb + n0 + bn);
        else if (MODE == 1) bv = *(const f32x4*)(B + (size_t)(k0 + bk) * ldb + n0 + DFF + bn);
        __syncthreads();
        As[(ak + 0) * 132 + ar] = av.x; As[(ak + 1) * 132 + ar] = av.y; As[(ak + 2) * 132 + ar] = av.z; As[(ak + 3) * 132 + ar] = av.w;
        if (tid < 256) *(f32x4*)(Bs + bk * 68 + bn) = bv;
        else if (MODE == 1) *(f32x4*)(Bs2 + bk * 68 + bn) = bv;
        __syncthreads();
#pragma unroll
        for (int k = 0; k < 16; ++k) {
            const f32x4 a4 = *(const f32x4*)(As + k * 132 + tm * 4);
            const f32x4 b4 = *(const f32x4*)(Bs + k * 68 + tn * 4);
            const float a_[4] = {a4.x, a4.y, a4.z, a4.w}, b_[4] = {b4.x, b4.y, b4.z, b4.w};
#pragma unroll
            for (int i = 0; i < 4; ++i)
#pragma unroll
                for (int j = 0; j < 4; ++j) acc[i][j] += a_[i] * b_[j];
            if (MODE == 1) {
                const f32x4 c4 = *(const f32x4*)(Bs2 + k * 68 + tn * 4);
                const float c_[4] = {c4.x, c4.y, c4.z, c4.w};
#pragma unroll
                for (int i = 0; i < 4; ++i)
#pragma unroll
                    for (int j = 0; j < 4; ++j) acc2[i][j] += a_[i] * c_[j];
            }
        }
    }
#pragma unroll
    for (int i = 0; i < 4; ++i) {
        const int r = m0 + tm * 4 + i;
        if (MODE != 0 && r >= nvalid) continue;
        const size_t orow = (MODE == 0) ? (size_t)r : (size_t)list[r];
        f32x4 o;
        float ov[4];
#pragma unroll
        for (int j = 0; j < 4; ++j) {
            const int n = n0 + tn * 4 + j;
            if (MODE == 0) ov[j] = acc[i][j];
            else if (MODE == 1) {
                float glu = acc[i][j] + bias[n], lin = acc2[i][j] + bias[n + DFF];
                glu = fminf(glu, 7.0f); lin = fminf(fmaxf(lin, -7.0f), 7.0f);
                ov[j] = glu * sigmoidf_(1.702f * glu) * (lin + 1.0f);
            } else ov[j] = acc[i][j] + bias[n];
        }
        o.x = ov[0]; o.y = ov[1]; o.z = ov[2]; o.w = ov[3];
        *(f32x4*)(C + orow * ldc + n0 + tn * 4) = o;
    }
    __syncthreads();
}

__device__ __forceinline__ void naive_gemm_plain(Frame& F, const float* A, int lda, const float* B, int ldb, float* C, int ldc, int M, int N, int K) {
    const int nM = M / 128, nN = N / 64;
    for (int t = F.bid; t < nM * nN; t += F.G) {
        const int tmi = t / nN, tni = t % nN;
        naive_tile<0>(F, A, lda, nullptr, 0, tmi * 128, B, ldb, tni * 64, K, C, ldc, nullptr);
    }
}

__device__ __forceinline__ void ph_mods(Frame& F) {
    float* sc = (float*)F.lds;
    float* red = sc + 4096;
    float* mods = (float*)(F.ws + WS_MODS);
    const float* c = F.in[I_C]; const float* w = F.in[I_WADA]; const float* bb = F.in[I_BADA];
    for (int cg = F.bid; cg < NMOD / 256; cg += F.G) {
        __syncthreads();
        for (int i = F.tid; i < 4096; i += NTHR) { const float v = c[i]; sc[i] = v / (1.0f + expf(-v)); }
        __syncthreads();
        f32x4 acc[4];
#pragma unroll
        for (int b = 0; b < 4; ++b) acc[b] = (f32x4){0.f, 0.f, 0.f, 0.f};
        const int kb = F.wave * 128;
        for (int k = kb; k < kb + 128; ++k) {
            const f32x4 wv = *(const f32x4*)(w + (size_t)k * NMOD + cg * 256 + F.lane * 4);
#pragma unroll
            for (int b = 0; b < 4; ++b) acc[b] += sc[b * 1024 + k] * wv;
        }
#pragma unroll
        for (int b = 0; b < 4; ++b) *(f32x4*)(red + ((F.wave * 4 + b) * 256 + F.lane * 4)) = acc[b];
        __syncthreads();
        for (int i = F.tid; i < 1024; i += NTHR) {
            const int b = i >> 8, col = i & 255;
            float s = 0.f;
#pragma unroll
            for (int wv = 0; wv < 8; ++wv) s += red[(wv * 4 + b) * 256 + col];
            mods[b * NMOD + cg * 256 + col] = s + bb[cg * 256 + col];
        }
    }
    __syncthreads();
}

__device__ __forceinline__ void ph_h1(Frame& F) {
    const float* mods = (const float*)(F.ws + WS_MODS);
    float* H = (float*)(F.ws + WS_HBUF);
    const float* g = F.in[I_GPRE];
    for (int row = F.bid * NWAVES + F.wave; row < NTOK; row += F.G * NWAVES) {
        const int b = row / SEQ;
        f32x4 v[4]; row_load(F.in[I_X] + (size_t)row * DM, F.lane, v);
        const float rstd = rsqrtf(row_sumsq(v) * (1.0f / DM) + RMS_EPS);
#pragma unroll
        for (int j = 0; j < 4; ++j) {
            const int c0 = (j * 64 + F.lane) * 4;
            const f32x4 gg = *(const f32x4*)(g + c0), sh = *(const f32x4*)(mods + b * NMOD + c0), scv = *(const f32x4*)(mods + b * NMOD + DM + c0);
            v[j] = v[j] * rstd * gg * (1.0f + scv) + sh;
        }
        row_store(H + (size_t)row * DM, F.lane, v);
    }
}

__device__ __forceinline__ void ph_rope(Frame& F) {
    float* P = (float*)(F.ws + WS_PROJ);
    const int total = NTOK * 10 * 32;
    for (int idx = F.bid * NTHR + F.tid; idx < total; idx += F.G * NTHR) {
        const int i = idx & 31, hh = (idx >> 5) % 10, tok = idx / 320;
        const int cb = hh < 8 ? hh * 64 : COL_K + (hh - 8) * 64;
        const int pos = tok % SEQ;
        const float inv = powf(10000.0f, -(float)i * (2.0f / 64.0f));
        const float ang = (float)pos * inv;
        const float cs = cosf(ang), sn = sinf(ang);
        float* p = P + (size_t)tok * INW + cb + i;
        const float t1 = p[0], t2 = p[32];
        p[0] = t1 * cs - t2 * sn; p[32] = t2 * cs + t1 * sn;
    }
}

__device__ __forceinline__ void ph_attn(Frame& F) {
    const float* P = (const float*)(F.ws + WS_PROJ);
    float* O = (float*)(F.ws + WS_ATT);
    const float* sink = F.in[I_SINK];
    for (int it = F.bid * NWAVES + F.wave; it < NTOK * NQH; it += F.G * NWAVES) {
        const int qh = it & 7, tok = it >> 3, b = tok / SEQ, t = tok % SEQ, kvh = qh >> 2;
        const float q = P[(size_t)tok * INW + qh * 64 + F.lane] * 0.125f;
        float m = sink[qh], l = 1.0f, o = 0.0f;
        const int j0 = t - WIN < 0 ? 0 : t - WIN, j1 = t + WIN > SEQ - 1 ? SEQ - 1 : t + WIN;
        for (int j = j0; j <= j1; ++j) {
            const float* kr = P + (size_t)(b * SEQ + j) * INW;
            const float s = wave_sum(q * kr[COL_K + kvh * 64 + F.lane]);
            const float mn = fmaxf(m, s), corr = expf(m - mn), p = expf(s - mn);
            l = l * corr + p; o = o * corr + p * kr[COL_V + kvh * 64 + F.lane]; m = mn;
        }
        O[(size_t)tok * AW + qh * 64 + F.lane] = o / l;
    }
}

__device__ __forceinline__ void ph_s5(Frame& F) {
    const float* P = (const float*)(F.ws + WS_PROJ);
    float* Y = (float*)(F.ws + WS_YSSM);
    float* us = (float*)F.lds;
    float* ys = us + 1024;
    if (F.wave != 0) return;
    const int lane = F.lane;
    for (int item = F.bid; item < BATCH * NG * 2; item += F.G) {
        const int dir = item & 1, g = (item >> 1) % NG, b = item / (2 * NG);
        const int pi = (dir * NG + g) * PST + lane;
        const float a_re = F.in[I_ARE][pi], a_im = F.in[I_AIM][pi];
        const float dt = expf(F.in[I_LOGDT][dir * NG + g]);
        const float lr = a_re * dt, li = a_im * dt, mag = expf(lr);
        const float abr = mag * cosf(li), abi = mag * sinf(li);
        const float den = a_re * a_re + a_im * a_im, nr = abr - 1.0f, ni = abi;
        const float f_r = (nr * a_re + ni * a_im) / den, f_i = (ni * a_re - nr * a_im) / den;
        float bbr[16], bbi[16], cr[16], ci[16];
#pragma unroll
        for (int h = 0; h < 16; ++h) {
            const float br = F.in[I_BRE][(size_t)pi * CH + h], bi = F.in[I_BIM][(size_t)pi * CH + h];
            bbr[h] = f_r * br - f_i * bi; bbi[h] = f_r * bi + f_i * br;
            cr[h] = F.in[I_CRE][((size_t)(dir * NG + g) * CH + h) * PST + lane];
            ci[h] = F.in[I_CIM][((size_t)(dir * NG + g) * CH + h) * PST + lane];
        }
        float sr = 0.f, si = 0.f;
        for (int c = 0; c < SEQ / 64; ++c) {
            const int t0 = dir ? (SEQ - 64 - c * 64) : c * 64;
            {
                const float* ur = P + (size_t)(b * SEQ + t0 + lane) * INW + COL_U + g * CH;
#pragma unroll
                for (int q = 0; q < 4; ++q) *(f32x4*)(us + lane * 16 + q * 4) = *(const f32x4*)(ur + q * 4);
            }
            __builtin_amdgcn_s_waitcnt(0);
            __builtin_amdgcn_wave_barrier();
            for (int s = 0; s < 64; ++s) {
                const int tt = dir ? 63 - s : s;
                float u[16];
#pragma unroll
                for (int q = 0; q < 4; ++q) { const f32x4 t4 = *(const f32x4*)(us + tt * 16 + q * 4); u[q * 4] = t4.x; u[q * 4 + 1] = t4.y; u[q * 4 + 2] = t4.z; u[q * 4 + 3] = t4.w; }
                float bur = 0.f, bui = 0.f;
#pragma unroll
                for (int h = 0; h < 16; ++h) { bur += bbr[h] * u[h]; bui += bbi[h] * u[h]; }
                const float nsr = abr * sr - abi * si + bur, nsi = abr * si + abi * sr + bui;
                sr = nsr; si = nsi;
                float yv = 0.f;
#pragma unroll
                for (int h = 0; h < 16; ++h) { const float v = wave_sum(cr[h] * sr - ci[h] * si); yv = (lane == h) ? v : yv; }
                if (lane < 16) ys[tt * 16 + lane] = yv;
            }
            __builtin_amdgcn_s_waitcnt(0);
            __builtin_amdgcn_wave_barrier();
            {
                float* yr = Y + ((size_t)dir * NTOK + (size_t)(b * SEQ + t0 + lane)) * SW + g * CH;
#pragma unroll
                for (int q = 0; q < 4; ++q) *(f32x4*)(yr + q * 4) = *(const f32x4*)(ys + lane * 16 + q * 4);
            }
            __builtin_amdgcn_s_waitcnt(0);
            __builtin_amdgcn_wave_barrier();
        }
    }
}

__device__ __forceinline__ void ph_gelu(Frame& F) {
    const float* P = (const float*)(F.ws + WS_PROJ);
    const float* Y = (const float*)(F.ws + WS_YSSM);
    float* Gb = (float*)(F.ws + WS_G);
    const float* dsk = F.in[I_DSK];
    const int total = NTOK * SW / 4;
    for (int idx = F.bid * NTHR + F.tid; idx < total; idx += F.G * NTHR) {
        const int tok = idx / (SW / 4), c = (idx % (SW / 4)) * 4;
        const f32x4 u = *(const f32x4*)(P + (size_t)tok * INW + COL_U + c);
        const f32x4 y0 = *(const f32x4*)(Y + (size_t)tok * SW + c), y1 = *(const f32x4*)(Y + ((size_t)NTOK + tok) * SW + c);
        const f32x4 d = *(const f32x4*)(dsk + c);
        f32x4 v = d * u + y0 + y1;
        v.x = gelu_tanh(v.x); v.y = gelu_tanh(v.y); v.z = gelu_tanh(v.z); v.w = gelu_tanh(v.w);
        *(f32x4*)(Gb + (size_t)tok * SW + c) = v;
    }
}

__device__ __forceinline__ void ph_cat(Frame& F) {
    const float* Gb = (const float*)(F.ws + WS_G); const float* GL = (const float*)(F.ws + WS_GLUO);
    const float* AT = (const float*)(F.ws + WS_ATT); float* YC = (float*)(F.ws + WS_YCAT);
    for (int row = F.bid * NWAVES + F.wave; row < NTOK; row += F.G * NWAVES) {
        f32x4 a[2], s[2];
        float sa = 0.f, ss = 0.f;
#pragma unroll
        for (int j = 0; j < 2; ++j) {
            const int c0 = (j * 64 + F.lane) * 4;
            a[j] = *(const f32x4*)(AT + (size_t)row * AW + c0);
            const f32x4 gv = *(const f32x4*)(Gb + (size_t)row * SW + c0), gl = *(const f32x4*)(GL + (size_t)row * SW + c0), bg = *(const f32x4*)(F.in[I_BGLU] + c0);
            f32x4 z = gl + bg;
            z.x = sigmoidf_(z.x); z.y = sigmoidf_(z.y); z.z = sigmoidf_(z.z); z.w = sigmoidf_(z.w);
            s[j] = gv * z;
            sa += a[j].x * a[j].x + a[j].y * a[j].y + a[j].z * a[j].z + a[j].w * a[j].w;
            ss += s[j].x * s[j].x + s[j].y * s[j].y + s[j].z * s[j].z + s[j].w * s[j].w;
        }
        const float ra = rsqrtf(wave_sum(sa) * (1.0f / AW) + RMS_EPS), rs = rsqrtf(wave_sum(ss) * (1.0f / SW) + RMS_EPS);
#pragma unroll
        for (int j = 0; j < 2; ++j) {
            const int c0 = (j * 64 + F.lane) * 4;
            *(f32x4*)(YC + (size_t)row * DM + c0) = a[j] * ra * *(const f32x4*)(F.in[I_GATT] + c0);
            *(f32x4*)(YC + (size_t)row * DM + AW + c0) = s[j] * rs * *(const f32x4*)(F.in[I_GSSM] + c0);
        }
    }
}

__device__ __forceinline__ void ph_mid(Frame& F) {
    const float* mods = (const float*)(F.ws + WS_MODS);
    const float* YO = (const float*)(F.ws + WS_YO);
    float* XM = (float*)(F.ws + WS_XMID); float* H = (float*)(F.ws + WS_HBUF);
    int* topi = (int*)(F.ws + WS_TOPI); float* topg = (float*)(F.ws + WS_TOPG); int* elist = (int*)(F.ws + WS_ELIST);
    const float* wr = F.in[I_WR];
    for (int row = F.bid * NWAVES + F.wave; row < NTOK; row += F.G * NWAVES) {
        const int b = row / SEQ;
        f32x4 y[4], x[4]; row_load(YO + (size_t)row * DM, F.lane, y); row_load(F.in[I_X] + (size_t)row * DM, F.lane, x);
        const float ry = rsqrtf(row_sumsq(y) * (1.0f / DM) + RMS_EPS);
#pragma unroll
        for (int j = 0; j < 4; ++j) {
            const int c0 = (j * 64 + F.lane) * 4;
            x[j] = x[j] + *(const f32x4*)(mods + b * NMOD + 2 * DM + c0) * (y[j] * ry * *(const f32x4*)(F.in[I_GPOST] + c0));
        }
        row_store(XM + (size_t)row * DM, F.lane, x);
        const float rx = rsqrtf(row_sumsq(x) * (1.0f / DM) + RMS_EPS);
        f32x4 h[4];
#pragma unroll
        for (int j = 0; j < 4; ++j) {
            const int c0 = (j * 64 + F.lane) * 4;
            h[j] = x[j] * rx * *(const f32x4*)(F.in[I_GPREF] + c0) * (1.0f + *(const f32x4*)(mods + b * NMOD + 4 * DM + c0)) + *(const f32x4*)(mods + b * NMOD + 3 * DM + c0);
        }
        row_store(H + (size_t)row * DM, F.lane, h);
        float lg[32];
#pragma unroll
        for (int e = 0; e < 32; ++e) lg[e] = 0.f;
#pragma unroll
        for (int j = 0; j < 4; ++j) {
            const float hv[4] = {h[j].x, h[j].y, h[j].z, h[j].w};
#pragma unroll
            for (int q = 0; q < 4; ++q) {
                const float* wrow = wr + (size_t)((j * 64 + F.lane) * 4 + q) * NE;
#pragma unroll
                for (int e4 = 0; e4 < 8; ++e4) { const f32x4 w4 = *(const f32x4*)(wrow + e4 * 4);
                    lg[e4 * 4] += hv[q] * w4.x; lg[e4 * 4 + 1] += hv[q] * w4.y; lg[e4 * 4 + 2] += hv[q] * w4.z; lg[e4 * 4 + 3] += hv[q] * w4.w; }
            }
        }
        float mine = -3.0e38f;
#pragma unroll
        for (int e = 0; e < 32; ++e) { const float s = wave_sum(lg[e]); mine = (F.lane == e) ? s : mine; }
        if (F.lane < 32) mine += F.in[I_BR][F.lane];
        float tv[4]; int ti[4];
#pragma unroll
        for (int k = 0; k < 4; ++k) {
            const float mx = wave_max(mine);
            const unsigned long long bal = __ballot(mine == mx);
            const int idx = __ffsll((long long)bal) - 1;
            tv[k] = mx; ti[k] = idx;
            if (F.lane == idx) mine = -3.0e38f;
        }
        const float w1 = expf(tv[1] - tv[0]), w2 = expf(tv[2] - tv[0]), w3 = expf(tv[3] - tv[0]);
        const float inv = 1.0f / (1.0f + w1 + w2 + w3);
        const float gk[4] = {inv, w1 * inv, w2 * inv, w3 * inv};
#pragma unroll
        for (int k = 0; k < 4; ++k) {
            if (F.lane == k) {
                topi[row * 4 + k] = ti[k]; topg[row * 4 + k] = gk[k];
                const unsigned pos = atomicAdd(F.ctl + CW_ECNT + 64 * ti[k], 1u);
                elist[(size_t)ti[k] * NTOK + pos] = row * 4 + k;
            }
        }
    }
}

template <int MODE>
__device__ __forceinline__ void ph_moe(Frame& F) {
    const int* elist = (const int*)(F.ws + WS_ELIST);
    const float* H = (const float*)(F.ws + WS_HBUF);
    float* ACT = (float*)(F.ws + WS_ACT); float* YR = (float*)(F.ws + WS_YROWS);
    constexpr int NT = 1024 / 64, MT = NTOK / 128;
    for (int t = F.bid; t < NE * MT * NT; t += F.G) {
        const int nt = t % NT, mt = (t / NT) % MT, e = t / (NT * MT);
        const int cnt = (int)__hip_atomic_load(F.ctl + CW_ECNT + 64 * e, __ATOMIC_RELAXED, __HIP_MEMORY_SCOPE_AGENT);
        if (mt * 128 >= cnt) continue;
        if (MODE == 1) naive_tile<1>(F, H, DM, elist + (size_t)e * NTOK, cnt, mt * 128, F.in[I_WGU] + (size_t)e * DM * 2 * DFF, 2 * DFF, nt * 64, DM, ACT, DFF, F.in[I_BGU] + (size_t)e * 2 * DFF);
        else naive_tile<2>(F, ACT, DFF, elist + (size_t)e * NTOK, cnt, mt * 128, F.in[I_WD] + (size_t)e * DFF * DM, DM, nt * 64, DFF, YR, DM, F.in[I_BD] + (size_t)e * DM);
    }
}

__device__ __forceinline__ void ph_final(Frame& F) {
    const float* mods = (const float*)(F.ws + WS_MODS);
    const float* XM = (const float*)(F.ws + WS_XMID); const float* YR = (const float*)(F.ws + WS_YROWS);
    const float* topg = (const float*)(F.ws + WS_TOPG);
    for (int row = F.bid * NWAVES + F.wave; row < NTOK; row += F.G * NWAVES) {
        const int b = row / SEQ;
        f32x4 y[4];
#pragma unroll
        for (int j = 0; j < 4; ++j) y[j] = (f32x4){0.f, 0.f, 0.f, 0.f};
#pragma unroll
        for (int k = 0; k < 4; ++k) {
            const float gk = topg[row * 4 + k];
            f32x4 v[4]; row_load(YR + (size_t)(row * 4 + k) * DM, F.lane, v);
#pragma unroll
            for (int j = 0; j < 4; ++j) y[j] += gk * v[j];
        }
        const float ry = rsqrtf(row_sumsq(y) * (1.0f / DM) + RMS_EPS);
        f32x4 x[4]; row_load(XM + (size_t)row * DM, F.lane, x);
#pragma unroll
        for (int j = 0; j < 4; ++j) {
            const int c0 = (j * 64 + F.lane) * 4;
            x[j] = x[j] + *(const f32x4*)(mods + b * NMOD + 5 * DM + c0) * (y[j] * ry * *(const f32x4*)(F.in[I_GPOSTF] + c0));
        }
        row_store(F.out + (size_t)row * DM, F.lane, x);
    }
}

constexpr int NPH = 13;
struct Args { const float* in[29]; float* out; unsigned char* ws; int ph_lo, ph_hi; };

__global__ void __launch_bounds__(NTHR, 2) fwd_kernel(Args args) {
    extern __shared__ __attribute__((aligned(16))) unsigned char lds[];
    Frame F;
    F.lds = lds;
    F.tid = threadIdx.x; F.lane = F.tid & 63; F.wave = __builtin_amdgcn_readfirstlane(F.tid >> 6);
    F.bid = blockIdx.x; F.G = gridDim.x;
#pragma unroll
    for (int i = 0; i < 29; ++i) F.in[i] = args.in[i];
    F.out = args.out; F.ws = args.ws; F.ctl = (unsigned*)(args.ws + WS_CTL);
    volatile LAS unsigned* MISC = (volatile LAS unsigned*)((LAS unsigned char*)lds + MISC_OFF);
    if (F.tid < 32) MISC[F.tid] = 0u;
    __syncthreads();
    XcdBarrier bar; bar.bar = F.ctl + CW_BAR; bar.x = 0; bar.st = nullptr;
    if (MK_N_LAUNCHES == 1) bar = xcd_barrier_post(F.ctl + CW_BAR, MISC + 8);
    const int lo = args.ph_lo, hi = args.ph_hi;
#define IN(k) (lo <= (k) && (k) < hi)
#define SEAM(k) do { if (MK_N_LAUNCHES == 1 && IN(k) && IN((k) + 1)) xcd_barrier(bar); } while (0)
    float* HB = (float*)(F.ws + WS_HBUF); float* PJ = (float*)(F.ws + WS_PROJ);
    if (IN(0)) { ph_mods(F); } SEAM(0);
    if (IN(1)) { ph_h1(F); } SEAM(1);
    if (IN(2)) { naive_gemm_plain(F, HB, DM, F.in[I_WIN], INW, PJ, INW, NTOK, INW, DM); } SEAM(2);
    if (IN(3)) { ph_rope(F); } SEAM(3);
    if (IN(4)) { ph_attn(F); ph_s5(F); } SEAM(4);
    if (IN(5)) { ph_gelu(F); } SEAM(5);
    if (IN(6)) { naive_gemm_plain(F, (const float*)(F.ws + WS_G), SW, F.in[I_WGLU], SW, (float*)(F.ws + WS_GLUO), SW, NTOK, SW, SW); } SEAM(6);
    if (IN(7)) { ph_cat(F); } SEAM(7);
    if (IN(8)) { naive_gemm_plain(F, (const float*)(F.ws + WS_YCAT), DM, F.in[I_WOUT], DM, (float*)(F.ws + WS_YO), DM, NTOK, DM, DM); } SEAM(8);
    if (IN(9)) { ph_mid(F); } SEAM(9);
    if (IN(10)) { ph_moe<1>(F); } SEAM(10);
    if (IN(11)) { ph_moe<2>(F); } SEAM(11);
    if (IN(12)) { ph_final(F); }
#undef IN
#undef SEAM
}

extern "C" void kernel_launch(void* const* d_in, const int* in_sizes, int n_in, void* d_out, int out_size, void* d_ws, size_t ws_size, hipStream_t stream) {
    static int grid = 0;
    if (grid == 0) {
        if (n_in != 29 || ws_size < WS_END) { fprintf(stderr, "kernel_launch: unexpected n_in %d / ws %zu\n", n_in, ws_size); grid = -1; return; }
        int dev = 0, cus = 0, per_cu = 0;
        if (hipGetDevice(&dev) != hipSuccess || hipDeviceGetAttribute(&cus, hipDeviceAttributeMultiprocessorCount, dev) != hipSuccess) { grid = -1; return; }
        if (hipFuncSetAttribute((const void*)fwd_kernel, hipFuncAttributeMaxDynamicSharedMemorySize, LDS_BYTES) != hipSuccess) { fprintf(stderr, "kernel_launch: hipFuncSetAttribute failed\n"); grid = -1; return; }
        if (hipOccupancyMaxActiveBlocksPerMultiprocessor(&per_cu, (const void*)fwd_kernel, NTHR, LDS_BYTES) != hipSuccess || per_cu < 1)
            fprintf(stderr, "kernel_launch: occupancy query reports %d\n", per_cu);
        (void)hipGetLastError();
        grid = cus;
    }
    if (grid < 0) return;
    (void)hipMemsetAsync((char*)d_ws + WS_CTL, 0, CTL_ZERO_BYTES, stream);
    Args a{};
    for (int i = 0; i < 29; ++i) a.in[i] = (const float*)d_in[i];
    a.out = (float*)d_out; a.ws = (unsigned char*)d_ws;
    if (MK_N_LAUNCHES == 1) {
        a.ph_lo = 0; a.ph_hi = NPH;
        hipLaunchKernelGGL(fwd_kernel, dim3(grid), dim3(NTHR), LDS_BYTES, stream, a);
    } else {
        for (int p = 0; p < NPH; ++p) {
            a.ph_lo = p; a.ph_hi = p + 1;
            hipLaunchKernelGGL(fwd_kernel, dim3(grid), dim3(NTHR), LDS_BYTES, stream, a);
        }
    }
}
```

```cpp
#include <hip/hip_runtime.h>
#include <cstdio>
#include <cstdint>

#ifndef MK_N_LAUNCHES
#define MK_N_LAUNCHES 1
#endif

constexpr int BATCH = 4, SEQ = 4096, DM = 1024, NTOK = BATCH * SEQ;
constexpr int AW = 512, KVW = 128, SW = 512, INW = AW + 2 * KVW + SW;
constexpr int NQH = 8, NKVH = 2, HD = 64, WIN = 128;
constexpr int NG = 32, PST = 64, CH = 16;
constexpr int NE = 32, TOPK = 4, DFF = 1024;
constexpr int NMOD = 6 * DM;
constexpr float RMS_EPS = 1e-6f;
constexpr int COL_K = AW, COL_V = AW + KVW, COL_U = AW + 2 * KVW;

constexpr int NWAVES = 8, NTHR = NWAVES * 64;
constexpr int LDS_BYTES = 147456;
constexpr int MISC_OFF = 131072 + 320;

constexpr size_t MiB = 1u << 20;
constexpr size_t WS_CTL = 0, CTL_ZERO_BYTES = 1 * MiB;
constexpr size_t WS_MODS = 1 * MiB;
constexpr size_t WS_TOPI = 2 * MiB;
constexpr size_t WS_TOPG = 3 * MiB;
constexpr size_t WS_ELIST = 4 * MiB;
constexpr size_t WS_ROPE = 6 * MiB;
constexpr size_t WS_H1B = 8 * MiB;
constexpr size_t WS_PROJB = 40 * MiB;
constexpr size_t WS_ATTB = 80 * MiB;
constexpr size_t WS_EST = 96 * MiB;
constexpr size_t WS_UCAT = 112 * MiB;
constexpr size_t WS_WE = 136 * MiB;
constexpr size_t WS_WY = 144 * MiB;
constexpr size_t WS_GB = 176 * MiB;
constexpr size_t WS_YSB = 192 * MiB;
constexpr size_t WS_YCATB = 208 * MiB;
constexpr size_t WS_YOB = 240 * MiB;
constexpr size_t WS_XMID = 272 * MiB;
constexpr size_t WS_H2B = 336 * MiB;
constexpr size_t WS_WINT = 368 * MiB;
constexpr size_t WS_WOUTT = 371 * MiB;
constexpr size_t WS_WGLUT = 373 * MiB;
constexpr size_t WS_WGUT = 376 * MiB;
constexpr size_t WS_WDT = 504 * MiB;
constexpr int ACT_ROWS = NTOK * TOPK + NE * 256;
constexpr size_t WS_ACT = 568 * MiB;
constexpr size_t WS_YB = 712 * MiB;
constexpr size_t WS_END = 840 * MiB;
static_assert(WS_ACT + (size_t)ACT_ROWS * 1024 * 2 <= WS_YB, "ACT");

constexpr int CW_TMO = 0;
constexpr int CW_BAR = 4096;
constexpr int CW_ECNT = 16384;

#define LAS __attribute__((address_space(3)))
typedef float f32x4 __attribute__((ext_vector_type(4)));
typedef float f32x2v __attribute__((ext_vector_type(2)));
__device__ __forceinline__ f32x2v mk2(float a, float b) { f32x2v r; r.x = a; r.y = b; return r; }

#define XB_TMO      128
#define XB_XCNT(j)  (256  + 64 * (j))
#define XB_XSUB(j)  (1280 + 64 * (j))
#define XB_XGEN(j)  (2304 + 64 * (j))
#define XB_TOP      3328
#define XB_TOPGEN   3392
#define XCD_BAR_WORDS 3456
#define XB_SPIN_CAP (1u << 18)

__device__ __forceinline__ unsigned xb_ld(unsigned* p)              { return __hip_atomic_load(p, __ATOMIC_RELAXED, __HIP_MEMORY_SCOPE_AGENT); }
__device__ __forceinline__ unsigned xb_add(unsigned* p, unsigned v) { return __hip_atomic_fetch_add(p, v, __ATOMIC_RELAXED, __HIP_MEMORY_SCOPE_AGENT); }
__device__ __forceinline__ unsigned xb_xcc_id() { return (unsigned)__builtin_amdgcn_s_getreg((3 << 11) | 20) & 0xFu; }
#define XB_SPIN(cond, bar) do { unsigned _sp = 0; while (cond) { __builtin_amdgcn_s_sleep(1); \
    if ((++_sp & 255u) == 0u) { if (xb_ld(&(bar)[XB_TMO])) break; if (_sp > XB_SPIN_CAP) { atomicAdd(&(bar)[XB_TMO], 1u); break; } } } } while (0)

struct XcdBarrier { unsigned* bar; unsigned x; volatile LAS unsigned* st; };

__device__ __forceinline__ XcdBarrier xcd_barrier_post(unsigned* bar, volatile LAS unsigned* st) {
    XcdBarrier b; b.bar = bar; b.x = xb_xcc_id(); b.st = st;
    if (threadIdx.x == 0) (void)xb_add(&bar[XB_XCNT(b.x)], 1u);
    return b;
}
__device__ __forceinline__ void xcd_barrier_complete(unsigned* bar, unsigned x, unsigned& nloc, unsigned& nx) {
    const unsigned G = gridDim.x * gridDim.y * gridDim.z;
    unsigned sum, cnt, mine, sp = 0u;
    for (;;) {
        sum = 0u; cnt = 0u; mine = 0u;
#pragma unroll
        for (unsigned j = 0; j < 16; ++j) { const unsigned c = xb_ld(&bar[XB_XCNT(j)]); sum += c; cnt += (c > 0u) ? 1u : 0u; mine = (j == x) ? c : mine; }
        if (sum == G) break;
        __builtin_amdgcn_s_sleep(1);
        if ((++sp & 255u) == 0u) { if (xb_ld(&bar[XB_TMO])) break; if (sp > XB_SPIN_CAP) { atomicAdd(&bar[XB_TMO], 1u); break; } }
    }
    nloc = mine > 0u ? mine : 1u; nx = cnt > 0u ? cnt : 1u;
}
__device__ __forceinline__ void xcd_barrier(const XcdBarrier& b) {
    asm volatile("s_waitcnt vmcnt(0)" ::: "memory");
    __syncthreads();
    if (threadIdx.x == 0) {
        unsigned* bar = b.bar;
        __builtin_amdgcn_s_waitcnt(0);
        unsigned nloc = b.st[0], nx = b.st[1];
        if (nloc == 0u) { xcd_barrier_complete(bar, b.x, nloc, nx); b.st[0] = nloc; b.st[1] = nx; }
        const unsigned old = xb_add(&bar[XB_XSUB(b.x)], 1u);
        const unsigned gen = old / nloc;
        if (old + 1u == (gen + 1u) * nloc) {
            __builtin_amdgcn_fence(__ATOMIC_RELEASE, "agent");
            asm volatile("s_waitcnt vmcnt(0)" ::: "memory");
            const unsigned og = xb_add(&bar[XB_TOP], 1u);
            const unsigned tg = og / nx;
            if (og + 1u == (tg + 1u) * nx) xb_add(&bar[XB_TOPGEN], 1u);
            else XB_SPIN(xb_ld(&bar[XB_TOPGEN]) == tg, bar);
            __builtin_amdgcn_fence(__ATOMIC_ACQUIRE, "agent");
            xb_add(&bar[XB_XGEN(b.x)], 1u);
            asm volatile("s_waitcnt vmcnt(0)" ::: "memory");
        } else {
            XB_SPIN(xb_ld(&bar[XB_XGEN(b.x)]) == gen, bar);
            __builtin_amdgcn_fence(__ATOMIC_ACQUIRE, "agent");
            asm volatile("s_waitcnt vmcnt(0)" ::: "memory");
        }
    }
    __syncthreads();
}


namespace pg8 {
#define PG8_LAS __attribute__((address_space(3)))
typedef unsigned short bf16_t;
typedef short bf16x8 __attribute__((ext_vector_type(8)));
typedef float f32x4 __attribute__((ext_vector_type(4)));
typedef unsigned u32x4 __attribute__((ext_vector_type(4)));
constexpr int BM = 256, BK = 64, HALF = 128, HTB = HALF * BK * 2, STAGE_BYTES = 8 * HTB;

__host__ __device__ __forceinline__ int lds_byte(int r, int c) { const int st = (r >> 4) * 2 + (c >> 5), rr = r & 15, cc = c & 31, ob = rr * 64 + cc * 2; return st * 1024 + (ob ^ (((ob >> 9) & 1) << 5)); }
__host__ __device__ __forceinline__ void stage_rc(int b, int& R, int& C) { const int st = b / 1024, sb = b % 1024, swz = sb ^ (((sb >> 9) & 1) << 5); R = (st >> 1) * 16 + swz / 64; C = (st & 1) * 32 + (swz % 64) / 2; }
__host__ __device__ __forceinline__ int perm32(int rho) { const int n = rho >> 4, i = rho & 15; return 8 * (i >> 2) + 4 * n + (i & 3); }
__device__ __forceinline__ unsigned cvt_pk_bf16(float lo, float hi) { unsigned r; asm volatile("v_cvt_pk_bf16_f32 %0, %1, %2" : "=v"(r) : "v"(lo), "v"(hi)); return r; }

template <class P, class Epi, bool ALIGN_EPI>
__device__ __forceinline__ void gemm_phase(PG8_LAS unsigned char* lds, const P& S, const Epi& E) {
    const int tid = threadIdx.x, wid = __builtin_amdgcn_readfirstlane(tid >> 6), lane = tid & 63, wr = wid >> 2, wc = wid & 3, fr = lane & 15, fq = lane >> 4;
    const int nt = S.nt();
    int Rr[2], Cc[2]; unsigned voffB[2];
#pragma unroll
    for (int i = 0; i < 2; ++i) { int R, C; stage_rc(tid * 16 + i * 8192, R, C); Rr[i] = R; Cc[i] = C; const int Rb = Epi::PERM ? ((R & ~31) + perm32(R & 31)) : R;
        voffB[i] = (unsigned)(Rb * (nt * BK) + C) * 2u; }
    const size_t kstep = (size_t)(BK * 2);
    const size_t hstepB = (size_t)HALF * (nt * BK) * 2;
    const unsigned ldsw = (unsigned)wid * 1024u;
    const int aoff = lds_byte(wr * 64 + fr, fq * 8), boff = lds_byte(wc * 32 + fr, fq * 8);
#define PG8_SA(b, h) (((b) * 2 + (h)) * HTB)
#define PG8_SB(b, h) ((4 + (b) * 2 + (h)) * HTB)
#define PG8_STAGE(bufoff, gbase, voff) do { _Pragma("unroll") for (int _i = 0; _i < 2; ++_i) \
        __builtin_amdgcn_global_load_lds((const unsigned*)((const char*)(gbase) + (voff)[_i]), (PG8_LAS unsigned*)(lds + (bufoff) + ldsw + _i * 8192), 16, 0, 0); } while (0)
#define PG8_LDA(dst, b, h) do { _Pragma("unroll") for (int m = 0; m < 4; ++m) _Pragma("unroll") for (int k = 0; k < 2; ++k) dst[m][k] = *(const PG8_LAS bf16x8*)(lds + PG8_SA(b, h) + aoff + m * 2048 + k * 1024); } while (0)
#define PG8_LDB(dst, b, h) do { _Pragma("unroll") for (int n = 0; n < 2; ++n) _Pragma("unroll") for (int k = 0; k < 2; ++k) dst[n][k] = *(const PG8_LAS bf16x8*)(lds + PG8_SB(b, h) + boff + n * 2048 + k * 1024); } while (0)
#define PG8_MMA(ai, bj, At, Bt) do { __builtin_amdgcn_s_setprio(1); _Pragma("unroll") for (int m = 0; m < 4; ++m) _Pragma("unroll") for (int n = 0; n < 2; ++n) _Pragma("unroll") for (int k = 0; k < 2; ++k) \
        acc[ai][bj][m][n] = __builtin_amdgcn_mfma_f32_16x16x32_bf16(Bt[n][k], At[m][k], acc[ai][bj][m][n], 0, 0, 0); __builtin_amdgcn_s_setprio(0); } while (0)
#define PG8_WAIT_V(n) asm volatile("s_waitcnt vmcnt(" #n ")" ::: "memory")
#define PG8_WAIT_L(n) asm volatile("s_waitcnt lgkmcnt(" #n ")" ::: "memory")
#define PG8_BAR __builtin_amdgcn_s_barrier()
#define PG8_SCHED __builtin_amdgcn_sched_barrier(0)
    typename P::U cur, nxt; int ui = 0;
    if (!S.next(0, cur)) return;
    f32x4 acc[2][2][4][2];
#pragma unroll
    for (int a = 0; a < 2; ++a)
#pragma unroll
        for (int b = 0; b < 2; ++b)
#pragma unroll
            for (int m = 0; m < 4; ++m)
#pragma unroll
                for (int n = 0; n < 2; ++n) acc[a][b][m][n] = (f32x4){0.f, 0.f, 0.f, 0.f};
    bf16x8 At[4][2], B0[2][2], B1[2][2];
    unsigned vA[2][2], vN[2][2];
    S.a_off(cur, 0, Rr, Cc, vA);
    const char* cA = S.a_base(cur); const char* cB = S.b_base(cur);
    PG8_STAGE(PG8_SB(0, 0), cB, voffB); PG8_STAGE(PG8_SB(0, 1), cB + hstepB, voffB); PG8_STAGE(PG8_SA(0, 0), cA, vA[0]); PG8_STAGE(PG8_SA(0, 1), cA, vA[1]);
    if (wr == 1) PG8_BAR;
    PG8_WAIT_V(2); PG8_BAR;
    PG8_STAGE(PG8_SB(1, 0), cB + kstep, voffB); PG8_STAGE(PG8_SA(1, 0), cA + kstep, vA[0]); PG8_STAGE(PG8_SB(1, 1), cB + hstepB + kstep, voffB);
    PG8_WAIT_V(6); PG8_BAR;
    for (;;) {
        const bool has_next = S.next(ui + 1, nxt);
        const char* nA = cA; const char* nB = cB;
#pragma unroll
        for (int h = 0; h < 2; ++h)
#pragma unroll
            for (int i = 0; i < 2; ++i) vN[h][i] = vA[h][i];
        if (has_next) { nA = S.a_base(nxt); nB = S.b_base(nxt); S.a_off(nxt, ui + 1, Rr, Cc, vN); }
        for (int t = 0; t < nt; t += 2) {
            const bool last = (t == nt - 2);
            const char* a1 = cA + (size_t)(t + 1) * kstep;
            const char* a2 = last ? nA : cA + (size_t)(t + 2) * kstep; const char* b2 = last ? nB : cB + (size_t)(t + 2) * kstep;
            const char* a3 = a2 + kstep; const char* b3 = b2 + kstep;
            unsigned vX[2][2];
#pragma unroll
            for (int h = 0; h < 2; ++h)
#pragma unroll
                for (int i = 0; i < 2; ++i) vX[h][i] = last ? vN[h][i] : vA[h][i];
            PG8_LDB(B0, 0, 0); PG8_LDB(B1, 0, 1); PG8_SCHED; PG8_LDA(At, 0, 0); PG8_STAGE(PG8_SA(1, 1), a1, vA[1]);
            PG8_WAIT_V(8); PG8_WAIT_L(0); PG8_BAR; PG8_MMA(0, 0, At, B0); PG8_MMA(0, 1, At, B1); PG8_BAR; PG8_SCHED;
            PG8_LDA(At, 0, 1); PG8_STAGE(PG8_SB(0, 0), b2, voffB); PG8_STAGE(PG8_SB(0, 1), b2 + hstepB, voffB); PG8_STAGE(PG8_SA(0, 0), a2, vX[0]);
            PG8_WAIT_V(8); PG8_WAIT_L(0); PG8_BAR; PG8_MMA(1, 0, At, B0); PG8_MMA(1, 1, At, B1); PG8_BAR; PG8_SCHED;
            PG8_LDB(B0, 1, 0); PG8_LDB(B1, 1, 1); PG8_SCHED; PG8_LDA(At, 1, 0); PG8_STAGE(PG8_SA(0, 1), a2, vX[1]);
            PG8_WAIT_V(8); PG8_WAIT_L(0); PG8_BAR; PG8_MMA(0, 0, At, B0); PG8_MMA(0, 1, At, B1); PG8_BAR; PG8_SCHED;
            PG8_LDA(At, 1, 1); PG8_STAGE(PG8_SB(1, 0), b3, voffB); PG8_STAGE(PG8_SB(1, 1), b3 + hstepB, voffB); PG8_STAGE(PG8_SA(1, 0), a3, vX[0]);
            PG8_WAIT_V(8); PG8_WAIT_L(0); PG8_BAR; PG8_MMA(1, 0, At, B0); PG8_MMA(1, 1, At, B1); PG8_BAR; PG8_SCHED;
        }
        if constexpr (ALIGN_EPI) { if (wr == 0) PG8_BAR; }
        E(acc, cur, ui, wr, wc, fr, fq);
        if (!has_next) break;
#pragma unroll
        for (int a = 0; a < 2; ++a)
#pragma unroll
            for (int b = 0; b < 2; ++b)
#pragma unroll
                for (int m = 0; m < 4; ++m)
#pragma unroll
                    for (int n = 0; n < 2; ++n) acc[a][b][m][n] = (f32x4){0.f, 0.f, 0.f, 0.f};
        cur = nxt; cA = nA; cB = nB; ++ui;
#pragma unroll
        for (int h = 0; h < 2; ++h)
#pragma unroll
            for (int i = 0; i < 2; ++i) vA[h][i] = vN[h][i];
        if constexpr (ALIGN_EPI) { if (wr == 1) PG8_BAR; }
    }
    PG8_WAIT_V(0);
    if constexpr (!ALIGN_EPI) { if (wr == 0) PG8_BAR; }
    PG8_BAR;
#undef PG8_SA
#undef PG8_SB
#undef PG8_STAGE
#undef PG8_LDA
#undef PG8_LDB
#undef PG8_MMA
#undef PG8_WAIT_V
#undef PG8_WAIT_L
#undef PG8_BAR
#undef PG8_SCHED
}
}
typedef unsigned short bf16;
typedef unsigned v4u __attribute__((ext_vector_type(4)));
__device__ __forceinline__ unsigned f2bf(float f) { unsigned u = __builtin_bit_cast(unsigned, f); return (u + 0x7fffu + ((u >> 16) & 1u)) >> 16; }
__device__ __forceinline__ unsigned pk2(float lo, float hi) { return f2bf(lo) | (f2bf(hi) << 16); }
__device__ __forceinline__ float bf_lo(unsigned u) { return __builtin_bit_cast(float, u << 16); }
__device__ __forceinline__ float bf_hi(unsigned u) { return __builtin_bit_cast(float, u & 0xffff0000u); }
constexpr int XTRA_OFF = 131072 + 512;
constexpr int MAXU = 12;
constexpr int XT_ROWT = XTRA_OFF;
constexpr int XT_UNITS = XT_ROWT + MAXU * 1024;
constexpr int XT_TP = XT_UNITS + MAXU * 16;
static_assert(XT_TP + 40 * 4 <= LDS_BYTES, "LDS map");

struct Frame {
    unsigned char* lds;
    LAS unsigned char* ldsl;
    int tid, lane, wave, bid, G;
    const float* in[29];
    float* out;
    unsigned char* ws;
    unsigned* ctl;
};
enum { I_X = 0, I_C, I_WADA, I_BADA, I_GPRE, I_WIN, I_SINK, I_ARE, I_AIM, I_LOGDT, I_BRE, I_BIM, I_CRE, I_CIM, I_DSK, I_WGLU, I_BGLU,
       I_GATT, I_GSSM, I_WOUT, I_GPOST, I_GPREF, I_WR, I_BR, I_WGU, I_BGU, I_WD, I_BD, I_GPOSTF };

__device__ __forceinline__ float wave_sum(float v) {
#pragma unroll
    for (int o = 1; o < 64; o <<= 1) v += __shfl_xor(v, o);
    return v;
}
__device__ __forceinline__ float wave_max(float v) {
#pragma unroll
    for (int o = 1; o < 64; o <<= 1) v = fmaxf(v, __shfl_xor(v, o));
    return v;
}
__device__ __forceinline__ float fast_sigmoid(float x) { return __builtin_amdgcn_rcpf(1.0f + __builtin_amdgcn_exp2f(-1.4426950408889634f * x)); }
__device__ __forceinline__ float sigmoidf_(float x) { return 1.0f / (1.0f + expf(-x)); }
__device__ __forceinline__ float gelu_tanh(float x) { const float u = 0.7978845608028654f * (x + 0.044715f * x * x * x); return 0.5f * x * (1.0f + tanhf(u)); }

__device__ __forceinline__ void row_load(const float* row, int lane, f32x4 (&v)[4]) {
#pragma unroll
    for (int j = 0; j < 4; ++j) v[j] = *(const f32x4*)(row + (j * 64 + lane) * 4);
}
__device__ __forceinline__ void row_store(float* row, int lane, const f32x4 (&v)[4]) {
#pragma unroll
    for (int j = 0; j < 4; ++j) *(f32x4*)(row + (j * 64 + lane) * 4) = v[j];
}
__device__ __forceinline__ float row_sumsq(const f32x4 (&v)[4]) {
    float s = 0.f;
#pragma unroll
    for (int j = 0; j < 4; ++j) s += v[j].x * v[j].x + v[j].y * v[j].y + v[j].z * v[j].z + v[j].w * v[j].w;
    return wave_sum(s);
}

template <int MODE>
__device__ __forceinline__ void naive_tile(Frame& F, const float* A, int lda, const int* list, int nvalid, int m0,
                                           const float* B, int ldb, int n0, int K, float* C, int ldc, const float* bias) {
    float* As = (float*)F.lds;
    float* Bs = As + 16 * 132;
    float* Bs2 = Bs + 16 * 68;
    const int tid = F.tid, tm = tid >> 4, tn = tid & 15;
    float acc[4][4], acc2[4][4];
#pragma unroll
    for (int i = 0; i < 4; ++i)
#pragma unroll
        for (int j = 0; j < 4; ++j) { acc[i][j] = 0.f; acc2[i][j] = 0.f; }
    const int ar = tid >> 2, ak = (tid & 3) * 4;
    const float* arow = nullptr;
    {
        const int r = m0 + ar;
        if (MODE == 0) arow = A + (size_t)r * lda;
        else if (r < nvalid) { const int a = list[r]; arow = A + (size_t)(MODE == 1 ? (a >> 2) : a) * lda; }
    }
    const int bk = (tid & 255) >> 4, bn = (tid & 15) * 4;
    for (int k0 = 0; k0 < K; k0 += 16) {
        f32x4 av = (f32x4){0.f, 0.f, 0.f, 0.f};
        if (arow) av = *(const f32x4*)(arow + k0 + ak);
        f32x4 bv = (f32x4){0.f, 0.f, 0.f, 0.f};
        if (tid < 256) bv = *(const f32x4*)(B + (size_t)(k0 + bk) * ldb + n0 + bn);
        else if (MODE == 1) bv = *(const f32x4*)(B + (size_t)(k0 + bk) * ldb + n0 + DFF + bn);
        __syncthreads();
        As[(ak + 0) * 132 + ar] = av.x; As[(ak + 1) * 132 + ar] = av.y; As[(ak + 2) * 132 + ar] = av.z; As[(ak + 3) * 132 + ar] = av.w;
        if (tid < 256) *(f32x4*)(Bs + bk * 68 + bn) = bv;
        else if (MODE == 1) *(f32x4*)(Bs2 + bk * 68 + bn) = bv;
        __syncthreads();
#pragma unroll
        for (int k = 0; k < 16; ++k) {
            const f32x4 a4 = *(const f32x4*)(As + k * 132 + tm * 4);
            const f32x4 b4 = *(const f32x4*)(Bs + k * 68 + tn * 4);
            const float a_[4] = {a4.x, a4.y, a4.z, a4.w}, b_[4] = {b4.x, b4.y, b4.z, b4.w};
#pragma unroll
            for (int i = 0; i < 4; ++i)
#pragma unroll
                for (int j = 0; j < 4; ++j) acc[i][j] += a_[i] * b_[j];
            if (MODE == 1) {
                const f32x4 c4 = *(const f32x4*)(Bs2 + k * 68 + tn * 4);
                const float c_[4] = {c4.x, c4.y, c4.z, c4.w};
#pragma unroll
                for (int i = 0; i < 4; ++i)
#pragma unroll
                    for (int j = 0; j < 4; ++j) acc2[i][j] += a_[i] * c_[j];
            }
        }
    }
#pragma unroll
    for (int i = 0; i < 4; ++i) {
        const int r = m0 + tm * 4 + i;
        if (MODE != 0 && r >= nvalid) continue;
        const size_t orow = (MODE == 0) ? (size_t)r : (size_t)list[r];
        f32x4 o;
        float ov[4];
#pragma unroll
        for (int j = 0; j < 4; ++j) {
            const int n = n0 + tn * 4 + j;
            if (MODE == 0) ov[j] = acc[i][j];
            else if (MODE == 1) {
                float glu = acc[i][j] + bias[n], lin = acc2[i][j] + bias[n + DFF];
                glu = fminf(glu, 7.0f); lin = fminf(fmaxf(lin, -7.0f), 7.0f);
                ov[j] = glu * sigmoidf_(1.702f * glu) * (lin + 1.0f);
            } else ov[j] = acc[i][j] + bias[n];
        }
        o.x = ov[0]; o.y = ov[1]; o.z = ov[2]; o.w = ov[3];
        *(f32x4*)(C + orow * ldc + n0 + tn * 4) = o;
    }
    __syncthreads();
}

__device__ __forceinline__ void naive_gemm_plain(Frame& F, const float* A, int lda, const float* B, int ldb, float* C, int ldc, int M, int N, int K) {
    const int nM = M / 128, nN = N / 64;
    for (int t = F.bid; t < nM * nN; t += F.G) {
        const int tmi = t / nN, tni = t % nN;
        naive_tile<0>(F, A, lda, nullptr, 0, tmi * 128, B, ldb, tni * 64, K, C, ldc, nullptr);
    }
}

__device__ __forceinline__ void ssm_tables(struct Frame& F, int g);
__device__ __forceinline__ void ph_mods(Frame& F) {
    float* sc = (float*)F.lds;
    float* red = sc + 4096;
    float* mods = (float*)(F.ws + WS_MODS);
    const float* c = F.in[I_C]; const float* w = F.in[I_WADA]; const float* bb = F.in[I_BADA];
    for (int it = F.bid; it < NMOD / 256 + NG; it += F.G) {
        if (it >= NMOD / 256) { ssm_tables(F, it - NMOD / 256); continue; }
        const int cg = it;
        __syncthreads();
        for (int i = F.tid; i < 4096; i += NTHR) { const float v = c[i]; sc[i] = v / (1.0f + expf(-v)); }
        __syncthreads();
        f32x4 acc[4];
#pragma unroll
        for (int b = 0; b < 4; ++b) acc[b] = (f32x4){0.f, 0.f, 0.f, 0.f};
        const int kb = F.wave * 128;
        for (int k = kb; k < kb + 128; ++k) {
            const f32x4 wv = *(const f32x4*)(w + (size_t)k * NMOD + cg * 256 + F.lane * 4);
#pragma unroll
            for (int b = 0; b < 4; ++b) acc[b] += sc[b * 1024 + k] * wv;
        }
#pragma unroll
        for (int b = 0; b < 4; ++b) *(f32x4*)(red + ((F.wave * 4 + b) * 256 + F.lane * 4)) = acc[b];
        __syncthreads();
        for (int i = F.tid; i < 1024; i += NTHR) {
            const int b = i >> 8, col = i & 255;
            float s = 0.f;
#pragma unroll
            for (int wv = 0; wv < 8; ++wv) s += red[(wv * 4 + b) * 256 + col];
            mods[b * NMOD + cg * 256 + col] = s + bb[cg * 256 + col];
        }
    }
    __syncthreads();
}

__device__ __forceinline__ void ph_h1(Frame& F) {
    const float* mods = (const float*)(F.ws + WS_MODS);
    bf16* H = (bf16*)(F.ws + WS_H1B);
    const float* g = F.in[I_GPRE];
    for (int row = F.bid * NWAVES + F.wave; row < NTOK; row += F.G * NWAVES) {
        const int b = row / SEQ;
        f32x4 v[4]; row_load(F.in[I_X] + (size_t)row * DM, F.lane, v);
        const float rstd = rsqrtf(row_sumsq(v) * (1.0f / DM) + RMS_EPS);
#pragma unroll
        for (int j = 0; j < 4; ++j) {
            const int c0 = (j * 64 + F.lane) * 4;
            const f32x4 gg = *(const f32x4*)(g + c0), sh = *(const f32x4*)(mods + b * NMOD + c0), scv = *(const f32x4*)(mods + b * NMOD + DM + c0);
            v[j] = v[j] * rstd * gg * (1.0f + scv) + sh;
            uint2 w; w.x = pk2(v[j].x, v[j].y); w.y = pk2(v[j].z, v[j].w); *(uint2*)(H + (size_t)row * DM + c0) = w;
        }
    }
}

typedef float f32x16 __attribute__((ext_vector_type(16)));
constexpr int AT_KS = 0, AT_KSTRIDE = 144, AT_VT = 384 * AT_KSTRIDE, AT_VSTRIDE = 792;
static_assert(AT_VT + 64 * AT_VSTRIDE <= 131072, "attention LDS");
__device__ __forceinline__ void ph_attn(Frame& F) {
    const bf16* P = (const bf16*)(F.ws + WS_PROJB);
    bf16* O = (bf16*)(F.ws + WS_ATTB);
    LAS unsigned char* l = F.ldsl;
    const int lane = F.lane, c = lane & 31, hh = lane >> 5, g = F.wave & 3, th = F.wave >> 2;
    for (int unit = F.bid; unit < BATCH * (SEQ / 128) * NKVH; unit += F.G) {
        const int kvh = unit & 1, nb = (unit >> 1) & 31, b = unit >> 6;
        const int tok0 = nb * 128 - 128;
        __syncthreads();
#pragma unroll
        for (int i = 0; i < 6; ++i) {
            const int idx = F.tid + 512 * i, row = idx >> 3, c16 = idx & 7, pos = tok0 + row;
            v4u w = (v4u){0u, 0u, 0u, 0u};
            if (pos >= 0 && pos < SEQ) w = *(const v4u*)(P + (size_t)(b * SEQ + pos) * INW + COL_K + kvh * 64 + c16 * 8);
            *(LAS v4u*)(l + AT_KS + row * AT_KSTRIDE + c16 * 16) = w;
        }
#pragma unroll
        for (int i = 0; i < 3; ++i) {
            const int idx = F.tid + 512 * i, r2 = idx >> 3, c16 = idx & 7, pos = tok0 + 2 * r2;
            v4u w0 = (v4u){0u, 0u, 0u, 0u}, w1 = w0;
            if (pos >= 0 && pos < SEQ) { const bf16* vp = P + (size_t)(b * SEQ + pos) * INW + COL_V + kvh * 64 + c16 * 8; w0 = *(const v4u*)vp; w1 = *(const v4u*)(vp + INW); }
            const unsigned a0[4] = {w0.x, w0.y, w0.z, w0.w}, a1[4] = {w1.x, w1.y, w1.z, w1.w};
#pragma unroll
            for (int q = 0; q < 4; ++q) {
                const unsigned lo = (a0[q] & 0xffffu) | (a1[q] << 16), hi = (a0[q] >> 16) | (a1[q] & 0xffff0000u);
                *(LAS unsigned*)(l + AT_VT + (c16 * 8 + 2 * q) * AT_VSTRIDE + r2 * 4) = lo;
                *(LAS unsigned*)(l + AT_VT + (c16 * 8 + 2 * q + 1) * AT_VSTRIDE + r2 * 4) = hi;
            }
        }
        const int qh = kvh * 4 + g;
        const float sinkv = F.in[I_SINK][qh] * 1.4426950408889634f;
        __syncthreads();
#pragma unroll 1
        for (int qt = 0; qt < 2; ++qt) {
            const int qrel = 128 + th * 64 + qt * 32 + c;
            pg8::bf16x8 qf[4];
#pragma unroll
            for (int ks = 0; ks < 4; ++ks)
                qf[ks] = *(const pg8::bf16x8*)(P + (size_t)(b * SEQ + nb * 128 + th * 64 + qt * 32 + c) * INW + qh * 64 + ks * 16 + hh * 8);
            float m_run = sinkv, l_run = hh == 0 ? 1.0f : 0.0f;
            f32x16 o0, o1;
#pragma unroll
            for (int j = 0; j < 16; ++j) { o0[j] = 0.f; o1[j] = 0.f; }
            const int kt0 = th * 2 + qt;
#pragma unroll 1
            for (int kk = 0; kk < 9; ++kk) {
                const int kt = kt0 + kk;
                f32x16 s;
#pragma unroll
                for (int j = 0; j < 16; ++j) s[j] = 0.f;
#pragma unroll
                for (int ks = 0; ks < 4; ++ks) {
                    const pg8::bf16x8 kf = *(const LAS pg8::bf16x8*)(l + AT_KS + (kt * 32 + c) * AT_KSTRIDE + ks * 32 + hh * 16);
                    s = __builtin_amdgcn_mfma_f32_32x32x16_bf16(kf, qf[ks], s, 0, 0, 0);
                }
                const bool edge = (kk == 0) || (kk == 8) || (nb == 0) || (nb == SEQ / 128 - 1);
                float mx = -3.0e38f;
#pragma unroll
                for (int j = 0; j < 16; ++j) {
                    float v = s[j] * 1.4426950408889634f;
                    if (edge) {
                        const int krel = kt * 32 + (j & 3) + 8 * (j >> 2) + 4 * hh, d = qrel - krel, pos = tok0 + krel;
                        const bool ok = (d <= WIN) && (d >= -WIN) && (pos >= 0) && (pos < SEQ);
                        v = ok ? v : -1.0e30f;
                    }
                    s[j] = v; mx = fmaxf(mx, v);
                }
                mx = fmaxf(mx, __shfl_xor(mx, 32));
                const float m_new = fmaxf(m_run, mx), corr = __builtin_amdgcn_exp2f(m_run - m_new);
                m_run = m_new;
                float ps = 0.f;
#pragma unroll
                for (int j = 0; j < 16; ++j) { s[j] = __builtin_amdgcn_exp2f(s[j] - m_new); ps += s[j]; }
                l_run = l_run * corr + ps;
#pragma unroll
                for (int j = 0; j < 16; ++j) { o0[j] *= corr; o1[j] *= corr; }
#pragma unroll
                for (int st = 0; st < 2; ++st) {
                    typedef unsigned u32x4v __attribute__((ext_vector_type(4)));
                    u32x4v pw;
                    pw.x = pg8::cvt_pk_bf16(s[8 * st + 0], s[8 * st + 1]); pw.y = pg8::cvt_pk_bf16(s[8 * st + 2], s[8 * st + 3]);
                    pw.z = pg8::cvt_pk_bf16(s[8 * st + 4], s[8 * st + 5]); pw.w = pg8::cvt_pk_bf16(s[8 * st + 6], s[8 * st + 7]);
                    const pg8::bf16x8 pf = __builtin_bit_cast(pg8::bf16x8, pw);
                    const int kb = (kt * 32 + 16 * st + 4 * hh) * 2;
#pragma unroll
                    for (int dt = 0; dt < 2; ++dt) {
                        typedef unsigned u32x2v __attribute__((ext_vector_type(2)));
                        const u32x2v v0 = *(const LAS u32x2v*)(l + AT_VT + (dt * 32 + c) * AT_VSTRIDE + kb);
                        const u32x2v v1 = *(const LAS u32x2v*)(l + AT_VT + (dt * 32 + c) * AT_VSTRIDE + kb + 16);
                        u32x4v vw; vw.x = v0.x; vw.y = v0.y; vw.z = v1.x; vw.w = v1.y;
                        const pg8::bf16x8 vf = __builtin_bit_cast(pg8::bf16x8, vw);
                        if (dt == 0) o0 = __builtin_amdgcn_mfma_f32_32x32x16_bf16(vf, pf, o0, 0, 0, 0);
                        else o1 = __builtin_amdgcn_mfma_f32_32x32x16_bf16(vf, pf, o1, 0, 0, 0);
                    }
                }
            }
            const float lt = l_run + __shfl_xor(l_run, 32), inv = 1.0f / lt;
            bf16* orow = O + (size_t)(b * SEQ + nb * 128 + th * 64 + qt * 32 + c) * AW + qh * 64;
#pragma unroll
            for (int q = 0; q < 4; ++q) {
                uint2 w; w.x = pk2(o0[4 * q] * inv, o0[4 * q + 1] * inv); w.y = pk2(o0[4 * q + 2] * inv, o0[4 * q + 3] * inv);
                *(uint2*)(orow + 8 * q + 4 * hh) = w;
                w.x = pk2(o1[4 * q] * inv, o1[4 * q + 1] * inv); w.y = pk2(o1[4 * q + 2] * inv, o1[4 * q + 3] * inv);
                *(uint2*)(orow + 32 + 8 * q + 4 * hh) = w;
            }
        }
    }
    __syncthreads();
}

constexpr int TCH = 32, NCH = SEQ / TCH, NRR = BATCH * NCH;
constexpr int UK = 768, UK_U = 512;
__device__ __forceinline__ void ssm_tables(Frame& F, int g) {
    LAS f32x2v* BB = (LAS f32x2v*)(F.ldsl);
    LAS f32x2v* PW = (LAS f32x2v*)(F.ldsl + 16384);
    LAS f32x2v* CC = (LAS f32x2v*)(F.ldsl + 16384 + 33792);
    LAS bf16* KT = (LAS bf16*)(F.ldsl + 16384 + 33792 + 16384);
    bf16* WE = (bf16*)(F.ws + WS_WE) + (size_t)g * 256 * 512;
    bf16* WY = (bf16*)(F.ws + WS_WY) + (size_t)g * 512 * UK;
    __syncthreads();
    if (F.tid < 128) {
        const int dir = F.tid >> 6, p = F.tid & 63, pi = (dir * NG + g) * PST + p;
        const float a_re = F.in[I_ARE][pi], a_im = F.in[I_AIM][pi];
        const float dt = expf(F.in[I_LOGDT][dir * NG + g]);
        const float lr = a_re * dt, li = a_im * dt, mag = expf(lr);
        const float abr = mag * cosf(li), abi = mag * sinf(li);
        const float den = a_re * a_re + a_im * a_im, nr = abr - 1.0f, ni = abi;
        const float f_r = (nr * a_re + ni * a_im) / den, f_i = (ni * a_re - nr * a_im) / den;
        for (int h = 0; h < 16; ++h) {
            const float br = F.in[I_BRE][(size_t)pi * CH + h], bi = F.in[I_BIM][(size_t)pi * CH + h];
            BB[(dir * 64 + p) * 16 + h] = mk2(f_r * br - f_i * bi, f_r * bi + f_i * br);
        }
        for (int n = 0; n <= 32; ++n) { const float mg = expf(lr * (float)n), an = li * (float)n; PW[(dir * 64 + p) * 33 + n] = mk2(mg * cosf(an), mg * sinf(an)); }
    }
    for (int i = F.tid; i < 2048; i += NTHR) {
        const int dir = i >> 10, r = i & 1023;
        CC[i] = mk2(F.in[I_CRE][(size_t)(dir * NG + g) * CH * PST + r], F.in[I_CIM][(size_t)(dir * NG + g) * CH * PST + r]);
    }
    __syncthreads();
    for (int v = F.tid; v < 256 * 64; v += NTHR) {
        const int n = v >> 6, k8 = v & 63, dir = n >> 7, p = (n >> 1) & 63, ri = n & 1, j = k8 >> 1, h0 = (k8 & 1) * 8;
        const f32x2v pw = PW[(dir * 64 + p) * 33 + (dir ? j : 31 - j)];
        float o[8];
#pragma unroll
        for (int q = 0; q < 8; ++q) { const f32x2v bq = BB[(dir * 64 + p) * 16 + h0 + q]; o[q] = ri ? (pw.x * bq.y + pw.y * bq.x) : (pw.x * bq.x - pw.y * bq.y); }
        v4u w; w.x = pk2(o[0], o[1]); w.y = pk2(o[2], o[3]); w.z = pk2(o[4], o[5]); w.w = pk2(o[6], o[7]);
        *(v4u*)(WE + (size_t)n * 512 + k8 * 8) = w;
    }
    for (int v = F.tid; v < 512 * 32; v += NTHR) {
        const int row = v >> 5, c8 = v & 31, i = row >> 4, h = row & 15, dir = c8 >> 4, p0 = (c8 & 15) * 4;
        float o[8];
#pragma unroll
        for (int q = 0; q < 4; ++q) {
            const f32x2v cq = CC[(dir * 16 + h) * 64 + p0 + q], pw = PW[(dir * 64 + p0 + q) * 33 + (dir ? 32 - i : i + 1)];
            o[2 * q] = cq.x * pw.x - cq.y * pw.y; o[2 * q + 1] = -(cq.x * pw.y + cq.y * pw.x);
        }
        v4u w; w.x = pk2(o[0], o[1]); w.y = pk2(o[2], o[3]); w.z = pk2(o[4], o[5]); w.w = pk2(o[6], o[7]);
        *(v4u*)(WY + (size_t)row * UK + UK_U + c8 * 8) = w;
    }
    for (int e = F.tid; e < 63 * 256; e += NTHR) {
        const int ti = e >> 8, h = (e >> 4) & 15, hi = e & 15, tau = ti - 31, at = tau < 0 ? -tau : tau;
        float acc = 0.f;
        if (tau >= 0) for (int p = 0; p < 64; ++p) { const f32x2v cq = CC[h * 64 + p], pw = PW[p * 33 + at], bq = BB[p * 16 + hi];
            const float mr = cq.x * pw.x - cq.y * pw.y, mi = cq.x * pw.y + cq.y * pw.x; acc += mr * bq.x - mi * bq.y; }
        if (tau <= 0) for (int p = 0; p < 64; ++p) { const f32x2v cq = CC[(16 + h) * 64 + p], pw = PW[(64 + p) * 33 + at], bq = BB[(64 + p) * 16 + hi];
            const float mr = cq.x * pw.x - cq.y * pw.y, mi = cq.x * pw.y + cq.y * pw.x; acc += mr * bq.x - mi * bq.y; }
        if (tau == 0 && h == hi) acc += F.in[I_DSK][g * CH + h];
        KT[e] = (bf16)f2bf(acc);
    }
    __syncthreads();
    for (int v = F.tid; v < 512 * 64; v += NTHR) {
        const int row = v >> 6, k8 = v & 63, i = row >> 4, h = row & 15, j = k8 >> 1, hi0 = (k8 & 1) * 8;
        *(v4u*)(WY + (size_t)row * UK + k8 * 8) = *(const LAS v4u*)(KT + ((i - j + 31) * 16 + h) * 16 + hi0);
    }
    __syncthreads();
}

struct GrpUnit { int g, pm, pn; };
struct GrpProb {
    typedef GrpUnit U;
    const char* A; const char* B; size_t a_gs, b_gs; int lda_b; int K; int nN, total, G, vb;
    __device__ __forceinline__ int nt() const { return K / 64; }
    __device__ __forceinline__ bool next(int i, U& u) const { const int L = i * G + vb; if (L >= total) return false; u.g = L / (2 * nN); const int r = L % (2 * nN); u.pm = r / nN; u.pn = r % nN; return true; }
    __device__ __forceinline__ const char* a_base(const U& u) const { return A + u.g * a_gs + (size_t)u.pm * 256 * lda_b; }
    __device__ __forceinline__ const char* b_base(const U& u) const { return B + u.g * b_gs + (size_t)u.pn * 256 * K * 2; }
    __device__ __forceinline__ void a_off(const U&, int, const int (&R)[2], const int (&C)[2], unsigned (&v)[2][2]) const {
#pragma unroll
        for (int h = 0; h < 2; ++h)
#pragma unroll
            for (int i = 0; i < 2; ++i) v[h][i] = (unsigned)((h * 128 + R[i]) * lda_b + C[i] * 2);
    }
};
struct EpiEst {
    static constexpr bool PERM = false;
    float* EST;
    __device__ __forceinline__ void operator()(const pg8::f32x4 (&acc)[2][2][4][2], const GrpUnit& u, int, int wr, int wc, int fr, int fq) const {
#pragma unroll
        for (int ai = 0; ai < 2; ++ai)
#pragma unroll
            for (int m = 0; m < 4; ++m) {
                float* rowp = EST + ((size_t)u.g * NRR + u.pm * 256 + ai * 128 + wr * 64 + m * 16 + fr) * 256 + wc * 32 + 4 * fq;
#pragma unroll
                for (int bj = 0; bj < 2; ++bj)
#pragma unroll
                    for (int n = 0; n < 2; ++n) *(f32x4*)(rowp + bj * 128 + n * 16) = acc[ai][bj][m][n];
            }
    }
};
__device__ __forceinline__ float fast_gelu_tanh(float x) {
    const float u = 0.7978845608028654f * (x + 0.044715f * x * x * x);
    const float t = 1.0f - 2.0f * __builtin_amdgcn_rcpf(__builtin_amdgcn_exp2f(2.885390081777927f * u) + 1.0f);
    return 0.5f * x * (1.0f + t);
}
struct EpiSsmY {
    static constexpr bool PERM = true;
    bf16* Gb;
    __device__ __forceinline__ void operator()(const pg8::f32x4 (&acc)[2][2][4][2], const GrpUnit& u, int, int wr, int wc, int fr, int fq) const {
#pragma unroll
        for (int ai = 0; ai < 2; ++ai)
#pragma unroll
            for (int m = 0; m < 4; ++m) {
                const int rr = u.pm * 256 + ai * 128 + wr * 64 + m * 16 + fr, b = rr >> 7, ch = rr & 127;
#pragma unroll
                for (int bj = 0; bj < 2; ++bj) {
                    const int n0 = u.pn * 256 + bj * 128 + wc * 32 + 8 * fq, i = n0 >> 4, h0 = n0 & 15;
                    const f32x4 v0 = acc[ai][bj][m][0], v1 = acc[ai][bj][m][1];
                    v4u w; w.x = pk2(fast_gelu_tanh(v0[0]), fast_gelu_tanh(v0[1])); w.y = pk2(fast_gelu_tanh(v0[2]), fast_gelu_tanh(v0[3]));
                    w.z = pk2(fast_gelu_tanh(v1[0]), fast_gelu_tanh(v1[1])); w.w = pk2(fast_gelu_tanh(v1[2]), fast_gelu_tanh(v1[3]));
                    *(v4u*)(Gb + (size_t)(b * SEQ + ch * TCH + i) * SW + u.g * CH + h0) = w;
                }
            }
    }
};
__device__ __forceinline__ void ph_scan(Frame& F) {
    const float* EST = (const float*)(F.ws + WS_EST);
    bf16* UC = (bf16*)(F.ws + WS_UCAT);
    const int item = F.bid + F.G * F.wave;
    if (item >= BATCH * NG * 2) return;
    const int dir = item & 1, g = (item >> 1) & 31, b = item >> 6, p = F.lane;
    const int pi = (dir * NG + g) * PST + p;
    const float dt = expf(F.in[I_LOGDT][dir * NG + g]);
    const float lr = F.in[I_ARE][pi] * dt * (float)TCH, li = F.in[I_AIM][pi] * dt * (float)TCH, mg = expf(lr);
    const float ar = mg * cosf(li), ai = mg * sinf(li);
    const float* e0 = EST + ((size_t)g * NRR + b * NCH) * 256 + dir * 128 + p * 2;
    bf16* s0 = UC + ((size_t)g * NRR + b * NCH) * UK + UK_U + dir * 128 + p * 2;
    float sr = 0.f, si = 0.f;
    for (int cb = 0; cb < NCH; cb += 32) {
        float2 e[32];
#pragma unroll
        for (int q = 0; q < 32; ++q) { const int c = dir ? NCH - 1 - (cb + q) : cb + q; e[q] = *(const float2*)(e0 + (size_t)c * 256); }
#pragma unroll
        for (int q = 0; q < 32; ++q) {
            const int c = dir ? NCH - 1 - (cb + q) : cb + q;
            *(unsigned*)(s0 + (size_t)c * UK) = pk2(sr, si);
            const float nr = ar * sr - ai * si + e[q].x, ni = ar * si + ai * sr + e[q].y;
            sr = nr; si = ni;
        }
    }
}

__device__ __forceinline__ void ph_cat(Frame& F) {
    const bf16* YS = (const bf16*)(F.ws + WS_YSB);
    const bf16* AT = (const bf16*)(F.ws + WS_ATTB); bf16* YC = (bf16*)(F.ws + WS_YCATB);
    for (int row = F.bid * NWAVES + F.wave; row < NTOK; row += F.G * NWAVES) {
        f32x4 a[2], s[2];
        float sa = 0.f, ss = 0.f;
#pragma unroll
        for (int j = 0; j < 2; ++j) {
            const int c0 = (j * 64 + F.lane) * 4;
            const uint2 wa = *(const uint2*)(AT + (size_t)row * AW + c0);
            a[j] = (f32x4){bf_lo(wa.x), bf_hi(wa.x), bf_lo(wa.y), bf_hi(wa.y)};
            const uint2 w = *(const uint2*)(YS + (size_t)row * SW + c0);
            s[j] = (f32x4){bf_lo(w.x), bf_hi(w.x), bf_lo(w.y), bf_hi(w.y)};
            sa += a[j].x * a[j].x + a[j].y * a[j].y + a[j].z * a[j].z + a[j].w * a[j].w;
            ss += s[j].x * s[j].x + s[j].y * s[j].y + s[j].z * s[j].z + s[j].w * s[j].w;
        }
        const float ra = rsqrtf(wave_sum(sa) * (1.0f / AW) + RMS_EPS), rs = rsqrtf(wave_sum(ss) * (1.0f / SW) + RMS_EPS);
#pragma unroll
        for (int j = 0; j < 2; ++j) {
            const int c0 = (j * 64 + F.lane) * 4;
            const f32x4 oa = a[j] * ra * *(const f32x4*)(F.in[I_GATT] + c0), os = s[j] * rs * *(const f32x4*)(F.in[I_GSSM] + c0);
            uint2 w; w.x = pk2(oa.x, oa.y); w.y = pk2(oa.z, oa.w); *(uint2*)(YC + (size_t)row * DM + c0) = w;
            w.x = pk2(os.x, os.y); w.y = pk2(os.z, os.w); *(uint2*)(YC + (size_t)row * DM + AW + c0) = w;
        }
    }
}

__device__ __forceinline__ void ph_mid(Frame& F) {
    const float* mods = (const float*)(F.ws + WS_MODS);
    const bf16* YO = (const bf16*)(F.ws + WS_YOB);
    float* XM = (float*)(F.ws + WS_XMID); bf16* H = (bf16*)(F.ws + WS_H2B);
    int* topi = (int*)(F.ws + WS_TOPI); float* topg = (float*)(F.ws + WS_TOPG); int* elist = (int*)(F.ws + WS_ELIST);
    const float* wr = F.in[I_WR];
    for (int row = F.bid * NWAVES + F.wave; row < NTOK; row += F.G * NWAVES) {
        const int b = row / SEQ;
        f32x4 y[4], x[4]; row_load(F.in[I_X] + (size_t)row * DM, F.lane, x);
#pragma unroll
        for (int j = 0; j < 4; ++j) { const uint2 w = *(const uint2*)(YO + (size_t)row * DM + (j * 64 + F.lane) * 4); y[j] = (f32x4){bf_lo(w.x), bf_hi(w.x), bf_lo(w.y), bf_hi(w.y)}; }
        const float ry = rsqrtf(row_sumsq(y) * (1.0f / DM) + RMS_EPS);
#pragma unroll
        for (int j = 0; j < 4; ++j) {
            const int c0 = (j * 64 + F.lane) * 4;
            x[j] = x[j] + *(const f32x4*)(mods + b * NMOD + 2 * DM + c0) * (y[j] * ry * *(const f32x4*)(F.in[I_GPOST] + c0));
        }
        row_store(XM + (size_t)row * DM, F.lane, x);
        const float rx = rsqrtf(row_sumsq(x) * (1.0f / DM) + RMS_EPS);
        f32x4 h[4];
#pragma unroll
        for (int j = 0; j < 4; ++j) {
            const int c0 = (j * 64 + F.lane) * 4;
            h[j] = x[j] * rx * *(const f32x4*)(F.in[I_GPREF] + c0) * (1.0f + *(const f32x4*)(mods + b * NMOD + 4 * DM + c0)) + *(const f32x4*)(mods + b * NMOD + 3 * DM + c0);
        }
#pragma unroll
        for (int j = 0; j < 4; ++j) { uint2 w; w.x = pk2(h[j].x, h[j].y); w.y = pk2(h[j].z, h[j].w); *(uint2*)(H + (size_t)row * DM + (j * 64 + F.lane) * 4) = w; }
        float lg[32];
#pragma unroll
        for (int e = 0; e < 32; ++e) lg[e] = 0.f;
#pragma unroll
        for (int j = 0; j < 4; ++j) {
            const float hv[4] = {h[j].x, h[j].y, h[j].z, h[j].w};
#pragma unroll
            for (int q = 0; q < 4; ++q) {
                const float* wrow = wr + (size_t)((j * 64 + F.lane) * 4 + q) * NE;
#pragma unroll
                for (int e4 = 0; e4 < 8; ++e4) { const f32x4 w4 = *(const f32x4*)(wrow + e4 * 4);
                    lg[e4 * 4] += hv[q] * w4.x; lg[e4 * 4 + 1] += hv[q] * w4.y; lg[e4 * 4 + 2] += hv[q] * w4.z; lg[e4 * 4 + 3] += hv[q] * w4.w; }
            }
        }
        float mine = -3.0e38f;
#pragma unroll
        for (int e = 0; e < 32; ++e) { const float s = wave_sum(lg[e]); mine = (F.lane == e) ? s : mine; }
        if (F.lane < 32) mine += F.in[I_BR][F.lane];
        float tv[4]; int ti[4];
#pragma unroll
        for (int k = 0; k < 4; ++k) {
            const float mx = wave_max(mine);
            const unsigned long long bal = __ballot(mine == mx);
            const int idx = __ffsll((long long)bal) - 1;
            tv[k] = mx; ti[k] = idx;
            if (F.lane == idx) mine = -3.0e38f;
        }
        const float w1 = expf(tv[1] - tv[0]), w2 = expf(tv[2] - tv[0]), w3 = expf(tv[3] - tv[0]);
        const float inv = 1.0f / (1.0f + w1 + w2 + w3);
        const float gk[4] = {inv, w1 * inv, w2 * inv, w3 * inv};
#pragma unroll
        for (int k = 0; k < 4; ++k) {
            if (F.lane == k) {
                topi[row * 4 + k] = ti[k]; topg[row * 4 + k] = gk[k];
                const unsigned pos = atomicAdd(F.ctl + CW_ECNT + 64 * ti[k], 1u);
                elist[(size_t)ti[k] * NTOK + pos] = row * 4 + k;
            }
        }
    }
}

__device__ __forceinline__ void p0_transpose_item(const float* W, int ldw, int k0, int n0, bf16* dst, int ldk, int rstride, LAS float* scr, int lane) {
#pragma unroll 8
    for (int i = 0; i < 32; ++i) { const int kk = 2 * i + (lane >> 5); scr[kk * 33 + (lane & 31)] = W[(size_t)(k0 + kk) * ldw + n0 + (lane & 31)]; }
    asm volatile("s_waitcnt lgkmcnt(0)" ::: "memory");
    const int c = lane & 7;
#pragma unroll
    for (int j = 0; j < 4; ++j) { const int n = (lane >> 3) + 8 * j; const LAS float* s = scr + (8 * c) * 33 + n;
        v4u o; o.x = pk2(s[0 * 33], s[1 * 33]); o.y = pk2(s[2 * 33], s[3 * 33]); o.z = pk2(s[4 * 33], s[5 * 33]); o.w = pk2(s[6 * 33], s[7 * 33]);
        *(v4u*)(dst + (size_t)n * rstride * ldk + k0 + 8 * c) = o; }
    asm volatile("s_waitcnt lgkmcnt(0)" ::: "memory");
}
__device__ __forceinline__ void ph_convert(Frame& F) {
    LAS float* scr = (LAS float*)(F.ldsl + F.wave * 16384);
    const int gw = F.bid * NWAVES + F.wave, NGW = F.G * NWAVES;
    bf16* WGUT = (bf16*)(F.ws + WS_WGUT); bf16* WDT = (bf16*)(F.ws + WS_WDT);
    bf16* WINT = (bf16*)(F.ws + WS_WINT); bf16* WOUTT = (bf16*)(F.ws + WS_WOUTT); bf16* WGLUT = (bf16*)(F.ws + WS_WGLUT);
    constexpr int I_IN = 16 * 40, I_OUT = 16 * 32, I_GLU = 8 * 16, I_DENSE = I_IN + I_OUT + I_GLU;
    constexpr int I_GU = 16 * 64, I_D = 16 * 32;
    for (int it = gw; it < I_DENSE + NE * (I_GU + I_D); it += NGW) {
        int r = it;
        if (r < I_IN) {
            const int kb = r / 40, nb = r % 40, n0 = nb * 32;
            if (n0 < COL_V) { const int hb = n0 & ~63, e = (n0 >> 5) & 1; p0_transpose_item(F.in[I_WIN], INW, kb * 64, n0, WINT + (size_t)(hb + e) * DM, DM, 2, scr, F.lane); }
            else p0_transpose_item(F.in[I_WIN], INW, kb * 64, n0, WINT + (size_t)n0 * DM, DM, 1, scr, F.lane);
            continue;
        }
        r -= I_IN;
        if (r < I_OUT) { const int kb = r / 32, nb = r % 32; p0_transpose_item(F.in[I_WOUT], DM, kb * 64, nb * 32, WOUTT + (size_t)nb * 32 * DM, DM, 1, scr, F.lane); continue; }
        r -= I_OUT;
        if (r < I_GLU) { const int kb = r / 16, nb = r % 16; p0_transpose_item(F.in[I_WGLU], SW, kb * 64, nb * 32, WGLUT + (size_t)nb * 32 * SW, SW, 1, scr, F.lane); continue; }
        r -= I_GLU;
        const int e = r / (I_GU + I_D); r = r % (I_GU + I_D);
        if (r < I_GU) {
            const int kb = r / 64, nb = r % 64, n0 = nb * 32;
            const int bj = n0 >> 10, pn = (n0 & 1023) >> 7, o = n0 & 127, drow = pn * 256 + bj * 128 + o;
            p0_transpose_item(F.in[I_WGU] + (size_t)e * DM * 2 * DFF, 2 * DFF, kb * 64, n0, WGUT + ((size_t)e * 2 * DFF + drow) * DM, DM, 1, scr, F.lane);
        } else {
            r -= I_GU; const int kb = r / 32, nb = r % 32, n0 = nb * 32;
            p0_transpose_item(F.in[I_WD] + (size_t)e * DFF * DM, DM, kb * 64, n0, WDT + ((size_t)e * DM + n0) * DFF, DFF, 1, scr, F.lane);
        }
    }
    float2* rope = (float2*)(F.ws + WS_ROPE);
    for (int idx = F.bid * NTHR + F.tid; idx < SEQ * 32; idx += F.G * NTHR) {
        const int i = idx & 31, pos = idx >> 5;
        const float inv = powf(10000.0f, -(float)i * (2.0f / 64.0f));
        const float ang = (float)pos * inv;
        rope[idx] = make_float2(cosf(ang), sinf(ang));
    }
}

struct DenseUnit { int pm, pn; };
struct DenseProb {
    typedef DenseUnit U;
    const char* A; const char* B; int lda_b; int K; int nN, total, G, vb;
    __device__ __forceinline__ int nt() const { return K / 64; }
    __device__ __forceinline__ bool next(int i, U& u) const { const int L = i * G + vb; if (L >= total) return false; u.pm = L / nN; u.pn = L % nN; return true; }
    __device__ __forceinline__ const char* a_base(const U& u) const { return A + (size_t)u.pm * 256 * lda_b; }
    __device__ __forceinline__ const char* b_base(const U& u) const { return B + (size_t)u.pn * 256 * K * 2; }
    __device__ __forceinline__ void a_off(const U&, int, const int (&R)[2], const int (&C)[2], unsigned (&v)[2][2]) const {
#pragma unroll
        for (int h = 0; h < 2; ++h)
#pragma unroll
            for (int i = 0; i < 2; ++i) v[h][i] = (unsigned)((h * 128 + R[i]) * lda_b + C[i] * 2);
    }
};
__device__ __forceinline__ DenseProb dense_prob(Frame& F, const void* A, int lda, const void* Bt, int M, int N, int K) {
    DenseProb S; S.A = (const char*)A; S.B = (const char*)Bt; S.lda_b = lda * 2; S.K = K; S.nN = N / 256; S.total = (M / 256) * (N / 256); S.G = F.G;
    S.vb = (F.G % 8 == 0) ? (F.bid % 8) * (F.G / 8) + F.bid / 8 : F.bid;
    return S;
}
struct EpiInProj {
    static constexpr bool PERM = true;
    bf16* O; const float* rope; bf16* UC;
    __device__ __forceinline__ void operator()(const pg8::f32x4 (&acc)[2][2][4][2], const DenseUnit& u, int, int wr, int wc, int fr, int fq) const {
#pragma unroll
        for (int bj = 0; bj < 2; ++bj) {
            const int colbase = u.pn * 256 + bj * 128, c0 = colbase + wc * 32 + 8 * fq;
            const bool isrope = colbase < COL_V; const float qs = colbase < COL_K ? 0.125f : 1.0f;
            const int i0 = (c0 & 63) >> 1;
#pragma unroll
            for (int ai = 0; ai < 2; ++ai)
#pragma unroll
                for (int m = 0; m < 4; ++m) {
                    const int row = u.pm * 256 + ai * 128 + wr * 64 + m * 16 + fr, pos = row & (SEQ - 1);
                    f32x4 v0 = acc[ai][bj][m][0], v1 = acc[ai][bj][m][1];
                    if (isrope) {
                        const f32x4 r0 = *(const f32x4*)(rope + ((size_t)pos * 32 + i0) * 2), r1 = *(const f32x4*)(rope + ((size_t)pos * 32 + i0 + 2) * 2);
                        f32x4 w0, w1;
                        w0[0] = v0[0] * r0[0] - v0[1] * r0[1]; w0[1] = v0[1] * r0[0] + v0[0] * r0[1];
                        w0[2] = v0[2] * r0[2] - v0[3] * r0[3]; w0[3] = v0[3] * r0[2] + v0[2] * r0[3];
                        w1[0] = v1[0] * r1[0] - v1[1] * r1[1]; w1[1] = v1[1] * r1[0] + v1[0] * r1[1];
                        w1[2] = v1[2] * r1[2] - v1[3] * r1[3]; w1[3] = v1[3] * r1[2] + v1[2] * r1[3];
                        v0 = w0 * qs; v1 = w1 * qs;
                    }
                    v4u w; w.x = pg8::cvt_pk_bf16(v0[0], v0[1]); w.y = pg8::cvt_pk_bf16(v0[2], v0[3]); w.z = pg8::cvt_pk_bf16(v1[0], v1[1]); w.w = pg8::cvt_pk_bf16(v1[2], v1[3]);
                    if (colbase < COL_U) *(v4u*)(O + (size_t)row * INW + c0) = w;
                    else { const int cu = c0 - COL_U, g = cu >> 4, h0 = cu & 15, b = row >> 12, t = row & (SEQ - 1);
                        *(v4u*)(UC + ((size_t)g * NRR + b * NCH + (t >> 5)) * UK + (t & 31) * CH + h0) = w; }
                }
        }
    }
};
struct EpiGlu {
    static constexpr bool PERM = true;
    const bf16* Gb; bf16* YS; const float* bglu;
    __device__ __forceinline__ void operator()(const pg8::f32x4 (&acc)[2][2][4][2], const DenseUnit& u, int, int wr, int wc, int fr, int fq) const {
#pragma unroll
        for (int bj = 0; bj < 2; ++bj) {
            const int c0 = u.pn * 256 + bj * 128 + wc * 32 + 8 * fq;
            const f32x4 b0 = *(const f32x4*)(bglu + c0), b1 = *(const f32x4*)(bglu + c0 + 4);
#pragma unroll
            for (int ai = 0; ai < 2; ++ai)
#pragma unroll
                for (int m = 0; m < 4; ++m) {
                    const size_t row = (size_t)u.pm * 256 + ai * 128 + wr * 64 + m * 16 + fr;
                    const v4u gw = *(const v4u*)(Gb + row * SW + c0);
                    const f32x4 z0 = acc[ai][bj][m][0] + b0, z1 = acc[ai][bj][m][1] + b1;
                    const float g[8] = {bf_lo(gw.x), bf_hi(gw.x), bf_lo(gw.y), bf_hi(gw.y), bf_lo(gw.z), bf_hi(gw.z), bf_lo(gw.w), bf_hi(gw.w)};
                    float o[8];
#pragma unroll
                    for (int q = 0; q < 4; ++q) { o[q] = g[q] * fast_sigmoid(z0[q]); o[4 + q] = g[4 + q] * fast_sigmoid(z1[q]); }
                    v4u w; w.x = pg8::cvt_pk_bf16(o[0], o[1]); w.y = pg8::cvt_pk_bf16(o[2], o[3]); w.z = pg8::cvt_pk_bf16(o[4], o[5]); w.w = pg8::cvt_pk_bf16(o[6], o[7]);
                    *(v4u*)(YS + row * SW + c0) = w;
                }
        }
    }
};
struct EpiStoreBf16 {
    static constexpr bool PERM = true;
    bf16* O; int ldc;
    __device__ __forceinline__ void operator()(const pg8::f32x4 (&acc)[2][2][4][2], const DenseUnit& u, int, int wr, int wc, int fr, int fq) const {
#pragma unroll
        for (int ai = 0; ai < 2; ++ai)
#pragma unroll
            for (int m = 0; m < 4; ++m) {
                const size_t row = (size_t)u.pm * 256 + ai * 128 + wr * 64 + m * 16 + fr;
#pragma unroll
                for (int bj = 0; bj < 2; ++bj) {
                    const int c0 = u.pn * 256 + bj * 128 + wc * 32 + 8 * fq;
                    const f32x4 v0 = acc[ai][bj][m][0], v1 = acc[ai][bj][m][1];
                    v4u w; w.x = pg8::cvt_pk_bf16(v0[0], v0[1]); w.y = pg8::cvt_pk_bf16(v0[2], v0[3]); w.z = pg8::cvt_pk_bf16(v1[0], v1[1]); w.w = pg8::cvt_pk_bf16(v1[2], v1[3]);
                    *(v4u*)(O + row * ldc + c0) = w;
                }
            }
    }
};

struct MoeUnit { int mt, pn, e, mloc; };
template <int MODE>
__device__ __forceinline__ void moe_setup(Frame& F) {
    LAS int* tp = (LAS int*)(F.ldsl + XT_TP); LAS int* un = (LAS int*)(F.ldsl + XT_UNITS); LAS unsigned* rowt = (LAS unsigned*)(F.ldsl + XT_ROWT);
    const int* elist = (const int*)(F.ws + WS_ELIST);
    constexpr int NT = (MODE == 1) ? 8 : 4;
    __syncthreads();
    if (F.tid == 0) { int a = 0; for (int e = 0; e < NE; ++e) { tp[e] = a; a += ((int)F.ctl[CW_ECNT + 64 * e] + 255) >> 8; } tp[32] = a; }
    __syncthreads();
    const int total = tp[32] * NT;
    const int vb = (F.G % 8 == 0) ? (F.bid % 8) * (F.G / 8) + F.bid / 8 : F.bid;
    int n = 0;
    for (int L = vb; L < total && n < MAXU; L += F.G) ++n;
    if (F.tid < n) {
        const int L = vb + F.tid * F.G, mt = L / NT, pn = L % NT;
        int e = 0;
        for (int q = 1; q < NE; ++q) if (tp[q] <= mt) e = q;
        un[F.tid * 4 + 0] = mt; un[F.tid * 4 + 1] = pn; un[F.tid * 4 + 2] = e; un[F.tid * 4 + 3] = mt - tp[e];
    }
    if (F.tid == 0) tp[34] = n;
    __syncthreads();
    for (int j = 0; j < n; ++j) {
        if (F.tid < 256) {
            const int e = un[j * 4 + 2], mloc = un[j * 4 + 3], idx = mloc * 256 + F.tid;
            const int cnt = (int)F.ctl[CW_ECNT + 64 * e];
            const int a = idx < cnt ? elist[(size_t)e * NTOK + idx] : -1;
            rowt[j * 256 + F.tid] = (MODE == 1) ? (a >= 0 ? (unsigned)(a >> 2) * (unsigned)(DM * 2) : 0u) : (unsigned)a;
        }
    }
    __syncthreads();
}
template <int MODE> struct MoeProb {
    typedef MoeUnit U;
    LAS unsigned char* l; const char* A; const char* B;
    __device__ __forceinline__ int nt() const { return 16; }
    __device__ __forceinline__ bool next(int i, U& u) const {
        const LAS int* tp = (const LAS int*)(l + XT_TP); const LAS int* un = (const LAS int*)(l + XT_UNITS);
        const int n = __builtin_amdgcn_readfirstlane(tp[34]);
        if (i >= n) return false;
        u.mt = __builtin_amdgcn_readfirstlane(un[i * 4 + 0]); u.pn = __builtin_amdgcn_readfirstlane(un[i * 4 + 1]);
        u.e = __builtin_amdgcn_readfirstlane(un[i * 4 + 2]); u.mloc = __builtin_amdgcn_readfirstlane(un[i * 4 + 3]);
        return true;
    }
    __device__ __forceinline__ const char* a_base(const U& u) const { return MODE == 1 ? A : A + (size_t)u.mt * 256 * DFF * 2; }
    __device__ __forceinline__ const char* b_base(const U& u) const { return MODE == 1 ? B + ((size_t)u.e * 2 * DFF + u.pn * 256) * DM * 2 : B + ((size_t)u.e * DM + u.pn * 256) * DFF * 2; }
    __device__ __forceinline__ void a_off(const U&, int ui, const int (&R)[2], const int (&C)[2], unsigned (&v)[2][2]) const {
        const LAS unsigned* rowt = (const LAS unsigned*)(l + XT_ROWT) + ui * 256;
#pragma unroll
        for (int h = 0; h < 2; ++h)
#pragma unroll
            for (int i = 0; i < 2; ++i) v[h][i] = (MODE == 1) ? rowt[h * 128 + R[i]] + (unsigned)C[i] * 2u : (unsigned)((h * 128 + R[i]) * DFF + C[i]) * 2u;
    }
};
struct EpiGateUp {
    static constexpr bool PERM = true;
    bf16* ACT; const float* bgu;
    __device__ __forceinline__ void operator()(const pg8::f32x4 (&acc)[2][2][4][2], const MoeUnit& u, int, int wr, int wc, int fr, int fq) const {
        const float* bias = bgu + (size_t)u.e * 2 * DFF; const int j0 = u.pn * 128 + wc * 32 + 8 * fq;
        const f32x4 bg0 = *(const f32x4*)(bias + j0), bg1 = *(const f32x4*)(bias + j0 + 4), bl0 = *(const f32x4*)(bias + DFF + j0), bl1 = *(const f32x4*)(bias + DFF + j0 + 4);
#pragma unroll
        for (int ai = 0; ai < 2; ++ai)
#pragma unroll
            for (int m = 0; m < 4; ++m) {
                const size_t row = (size_t)u.mt * 256 + ai * 128 + wr * 64 + m * 16 + fr;
                f32x4 g0 = acc[ai][0][m][0] + bg0, g1 = acc[ai][0][m][1] + bg1, l0 = acc[ai][1][m][0] + bl0, l1 = acc[ai][1][m][1] + bl1;
                float o[8];
#pragma unroll
                for (int q = 0; q < 4; ++q) {
                    float g = fminf(g0[q], 7.0f), l = fminf(fmaxf(l0[q], -7.0f), 7.0f); o[q] = g * fast_sigmoid(1.702f * g) * (l + 1.0f);
                    g = fminf(g1[q], 7.0f); l = fminf(fmaxf(l1[q], -7.0f), 7.0f); o[4 + q] = g * fast_sigmoid(1.702f * g) * (l + 1.0f);
                }
                v4u w; w.x = pg8::cvt_pk_bf16(o[0], o[1]); w.y = pg8::cvt_pk_bf16(o[2], o[3]); w.z = pg8::cvt_pk_bf16(o[4], o[5]); w.w = pg8::cvt_pk_bf16(o[6], o[7]);
                *(v4u*)(ACT + row * DFF + j0) = w;
            }
    }
};
struct EpiDown {
    static constexpr bool PERM = true;
    bf16* YB; const float* bd; LAS unsigned char* l;
    __device__ __forceinline__ void operator()(const pg8::f32x4 (&acc)[2][2][4][2], const MoeUnit& u, int ui, int wr, int wc, int fr, int fq) const {
        const LAS int* rowt = (const LAS int*)(l + XT_ROWT) + ui * 256;
        const float* bias = bd + (size_t)u.e * DM; const int c0 = u.pn * 256 + wc * 32 + 8 * fq;
        f32x4 b0[2], b1[2];
#pragma unroll
        for (int bj = 0; bj < 2; ++bj) { b0[bj] = *(const f32x4*)(bias + c0 + bj * 128); b1[bj] = *(const f32x4*)(bias + c0 + bj * 128 + 4); }
#pragma unroll
        for (int ai = 0; ai < 2; ++ai)
#pragma unroll
            for (int m = 0; m < 4; ++m) {
                const int a = rowt[ai * 128 + wr * 64 + m * 16 + fr];
                v4u w[2];
#pragma unroll
                for (int bj = 0; bj < 2; ++bj) {
                    const f32x4 v0 = acc[ai][bj][m][0] + b0[bj], v1 = acc[ai][bj][m][1] + b1[bj];
                    w[bj].x = pg8::cvt_pk_bf16(v0[0], v0[1]); w[bj].y = pg8::cvt_pk_bf16(v0[2], v0[3]); w[bj].z = pg8::cvt_pk_bf16(v1[0], v1[1]); w[bj].w = pg8::cvt_pk_bf16(v1[2], v1[3]);
                }
                if (a >= 0) { *(v4u*)(YB + (size_t)a * DM + c0) = w[0]; *(v4u*)(YB + (size_t)a * DM + c0 + 128) = w[1]; }
            }
    }
};
template <int MODE>
__device__ __forceinline__ void ph_moe(Frame& F) {
    moe_setup<MODE>(F);
    if (MODE == 1) {
        MoeProb<1> S{F.ldsl, (const char*)(F.ws + WS_H2B), (const char*)(F.ws + WS_WGUT)};
        EpiGateUp E{(bf16*)(F.ws + WS_ACT), F.in[I_BGU]};
        pg8::gemm_phase<MoeProb<1>, EpiGateUp, true>(F.ldsl, S, E);
    } else {
        MoeProb<2> S{F.ldsl, (const char*)(F.ws + WS_ACT), (const char*)(F.ws + WS_WDT)};
        EpiDown E{(bf16*)(F.ws + WS_YB), F.in[I_BD], F.ldsl};
        pg8::gemm_phase<MoeProb<2>, EpiDown, true>(F.ldsl, S, E);
    }
    __syncthreads();
}

__device__ __forceinline__ void ph_final(Frame& F) {
    const float* mods = (const float*)(F.ws + WS_MODS);
    const float* XM = (const float*)(F.ws + WS_XMID); const bf16* YB = (const bf16*)(F.ws + WS_YB);
    const float* topg = (const float*)(F.ws + WS_TOPG);
    for (int row = F.bid * NWAVES + F.wave; row < NTOK; row += F.G * NWAVES) {
        const int b = row / SEQ;
        f32x4 y[4];
#pragma unroll
        for (int j = 0; j < 4; ++j) y[j] = (f32x4){0.f, 0.f, 0.f, 0.f};
#pragma unroll
        for (int k = 0; k < 4; ++k) {
            const float gk = topg[row * 4 + k];
            const bf16* yr = YB + (size_t)(row * 4 + k) * DM;
#pragma unroll
            for (int j = 0; j < 4; ++j) { const uint2 w = *(const uint2*)(yr + (j * 64 + F.lane) * 4);
                y[j] += gk * (f32x4){bf_lo(w.x), bf_hi(w.x), bf_lo(w.y), bf_hi(w.y)}; }
        }
        const float ry = rsqrtf(row_sumsq(y) * (1.0f / DM) + RMS_EPS);
        f32x4 x[4]; row_load(XM + (size_t)row * DM, F.lane, x);
#pragma unroll
        for (int j = 0; j < 4; ++j) {
            const int c0 = (j * 64 + F.lane) * 4;
            x[j] = x[j] + *(const f32x4*)(mods + b * NMOD + 5 * DM + c0) * (y[j] * ry * *(const f32x4*)(F.in[I_GPOSTF] + c0));
        }
        row_store(F.out + (size_t)row * DM, F.lane, x);
    }
}

constexpr int NPH = 13;
struct Args { const float* in[29]; float* out; unsigned char* ws; int ph_lo, ph_hi; };

__device__ __forceinline__ GrpProb grp_prob(Frame& F, const void* A, size_t a_gs, int lda, int K, const void* B, size_t b_gs, int N) {
    GrpProb S; S.A = (const char*)A; S.B = (const char*)B; S.a_gs = a_gs; S.b_gs = b_gs; S.lda_b = lda * 2; S.K = K; S.nN = N / 256; S.total = NG * 2 * (N / 256); S.G = F.G;
    S.vb = (F.G % 8 == 0) ? (F.bid % 8) * (F.G / 8) + F.bid / 8 : F.bid;
    return S;
}

__global__ void __launch_bounds__(NTHR, 2) fwd_kernel(Args args) {
    extern __shared__ __attribute__((aligned(16))) unsigned char lds[];
    Frame F;
    F.lds = lds; F.ldsl = (LAS unsigned char*)lds;
    F.tid = threadIdx.x; F.lane = F.tid & 63; F.wave = __builtin_amdgcn_readfirstlane(F.tid >> 6);
    F.bid = blockIdx.x; F.G = gridDim.x;
#pragma unroll
    for (int i = 0; i < 29; ++i) F.in[i] = args.in[i];
    F.out = args.out; F.ws = args.ws; F.ctl = (unsigned*)(args.ws + WS_CTL);
    volatile LAS unsigned* MISC = (volatile LAS unsigned*)((LAS unsigned char*)lds + MISC_OFF);
    if (F.tid < 32) MISC[F.tid] = 0u;
    __syncthreads();
    XcdBarrier bar; bar.bar = F.ctl + CW_BAR; bar.x = 0; bar.st = nullptr;
    if (MK_N_LAUNCHES == 1) bar = xcd_barrier_post(F.ctl + CW_BAR, MISC + 8);
    const int lo = args.ph_lo, hi = args.ph_hi;
#define IN(k) (lo <= (k) && (k) < hi)
#define SEAM(k) do { if (MK_N_LAUNCHES == 1 && IN(k) && IN((k) + 1)) xcd_barrier(bar); } while (0)
    if (IN(0)) { ph_mods(F); ph_convert(F); } SEAM(0);
    if (IN(1)) { ph_h1(F); } SEAM(1);
    if (IN(2)) {
        DenseProb S = dense_prob(F, F.ws + WS_H1B, DM, F.ws + WS_WINT, NTOK, INW, DM);
        EpiInProj E{(bf16*)(F.ws + WS_PROJB), (const float*)(F.ws + WS_ROPE), (bf16*)(F.ws + WS_UCAT)};
        pg8::gemm_phase<DenseProb, EpiInProj, true>(F.ldsl, S, E); __syncthreads();
    } SEAM(2);
    if (IN(3)) {
        ph_attn(F);
        GrpProb S = grp_prob(F, F.ws + WS_UCAT, (size_t)NRR * UK * 2, UK, UK_U, F.ws + WS_WE, (size_t)256 * 512 * 2, 256);
        EpiEst E{(float*)(F.ws + WS_EST)};
        pg8::gemm_phase<GrpProb, EpiEst, true>(F.ldsl, S, E); __syncthreads();
    } SEAM(3);
    if (IN(4)) { ph_scan(F); } SEAM(4);
    if (IN(5)) {
        GrpProb S = grp_prob(F, F.ws + WS_UCAT, (size_t)NRR * UK * 2, UK, UK, F.ws + WS_WY, (size_t)512 * UK * 2, 512);
        EpiSsmY E{(bf16*)(F.ws + WS_GB)};
        pg8::gemm_phase<GrpProb, EpiSsmY, true>(F.ldsl, S, E); __syncthreads();
    } SEAM(5);
    if (IN(6)) {
        DenseProb S = dense_prob(F, F.ws + WS_GB, SW, F.ws + WS_WGLUT, NTOK, SW, SW);
        EpiGlu E{(const bf16*)(F.ws + WS_GB), (bf16*)(F.ws + WS_YSB), F.in[I_BGLU]};
        pg8::gemm_phase<DenseProb, EpiGlu, true>(F.ldsl, S, E); __syncthreads();
    } SEAM(6);
    if (IN(7)) { ph_cat(F); } SEAM(7);
    if (IN(8)) {
        DenseProb S = dense_prob(F, F.ws + WS_YCATB, DM, F.ws + WS_WOUTT, NTOK, DM, DM);
        EpiStoreBf16 E{(bf16*)(F.ws + WS_YOB), DM};
        pg8::gemm_phase<DenseProb, EpiStoreBf16, true>(F.ldsl, S, E); __syncthreads();
    } SEAM(8);
    if (IN(9)) { ph_mid(F); } SEAM(9);
    if (IN(10)) { ph_moe<1>(F); } SEAM(10);
    if (IN(11)) { ph_moe<2>(F); } SEAM(11);
    if (IN(12)) { ph_final(F); }
#undef IN
#undef SEAM
}

extern "C" void kernel_launch(void* const* d_in, const int* in_sizes, int n_in, void* d_out, int out_size, void* d_ws, size_t ws_size, hipStream_t stream) {
    static int grid = 0;
    if (grid == 0) {
        if (n_in != 29 || ws_size < WS_END) { fprintf(stderr, "kernel_launch: unexpected n_in %d / ws %zu\n", n_in, ws_size); grid = -1; return; }
        int dev = 0, cus = 0, per_cu = 0;
        if (hipGetDevice(&dev) != hipSuccess || hipDeviceGetAttribute(&cus, hipDeviceAttributeMultiprocessorCount, dev) != hipSuccess) { grid = -1; return; }
        if (hipFuncSetAttribute((const void*)fwd_kernel, hipFuncAttributeMaxDynamicSharedMemorySize, LDS_BYTES) != hipSuccess) { fprintf(stderr, "kernel_launch: hipFuncSetAttribute failed\n"); grid = -1; return; }
        if (hipOccupancyMaxActiveBlocksPerMultiprocessor(&per_cu, (const void*)fwd_kernel, NTHR, LDS_BYTES) != hipSuccess || per_cu < 1)
            fprintf(stderr, "kernel_launch: occupancy query reports %d\n", per_cu);
        (void)hipGetLastError();
        grid = cus;
    }
    if (grid < 0) return;
    (void)hipMemsetAsync((char*)d_ws + WS_CTL, 0, CTL_ZERO_BYTES, stream);
    Args a{};
    for (int i = 0; i < 29; ++i) a.in[i] = (const float*)d_in[i];
    a.out = (float*)d_out; a.ws = (unsigned char*)d_ws;
    if (MK_N_LAUNCHES == 1) {
        a.ph_lo = 0; a.ph_hi = NPH;
        hipLaunchKernelGGL(fwd_kernel, dim3(grid), dim3(NTHR), LDS_BYTES, stream, a);
    } else {
        for (int p = 0; p < NPH; ++p) {
            a.ph_lo = p; a.ph_hi = p + 1;
            hipLaunchKernelGGL(fwd_kernel, dim3(grid), dim3(NTHR), LDS_BYTES, stream, a);
        }
    }
}
```

```cpp
#include <hip/hip_runtime.h>
#include <cstdio>
#include <cstdint>

#ifndef DUP_MASK
#define DUP_MASK 0x0
#endif
#ifndef MK_N_LAUNCHES
#define MK_N_LAUNCHES 1
#endif

constexpr int BATCH = 4, SEQ = 4096, DM = 1024, NTOK = BATCH * SEQ;
constexpr int AW = 512, KVW = 128, SW = 512, INW = AW + 2 * KVW + SW;
constexpr int NQH = 8, NKVH = 2, HD = 64, WIN = 128;
constexpr int NG = 32, PST = 64, CH = 16;
constexpr int NE = 32, TOPK = 4, DFF = 1024;
constexpr int NMOD = 6 * DM;
constexpr float RMS_EPS = 1e-6f;
constexpr int COL_K = AW, COL_V = AW + KVW, COL_U = AW + 2 * KVW;

constexpr int NWAVES = 8, NTHR = NWAVES * 64;
constexpr int LDS_BYTES = 147456;
constexpr int MISC_OFF = 131072 + 320;

constexpr size_t MiB = 1u << 20;
constexpr size_t WS_CTL = 0, CTL_ZERO_BYTES = 1 * MiB;
constexpr size_t WS_MODS = 1 * MiB;
constexpr size_t WS_TOPI = 2 * MiB;
constexpr size_t WS_TOPG = 3 * MiB;
constexpr size_t WS_ELIST = 4 * MiB;
constexpr size_t WS_ROPE = 6 * MiB;
constexpr size_t WS_H1B = 8 * MiB;
constexpr size_t WS_PROJB = 40 * MiB;
constexpr size_t WS_ATTB = 80 * MiB;
constexpr size_t WS_EST = 96 * MiB;
constexpr size_t WS_UCAT = 112 * MiB;
constexpr size_t WS_WE = 136 * MiB;
constexpr size_t WS_WY = 144 * MiB;
constexpr size_t WS_GB = 176 * MiB;
constexpr size_t WS_YSB = 192 * MiB;
constexpr size_t WS_YCATB = 208 * MiB;
constexpr size_t WS_YOB = 240 * MiB;
constexpr size_t WS_XMID = 272 * MiB;
constexpr size_t WS_H2B = 336 * MiB;
constexpr size_t WS_WINT = 368 * MiB;
constexpr size_t WS_WOUTT = 371 * MiB;
constexpr size_t WS_WGLUT = 373 * MiB;
constexpr size_t WS_WGUT = 376 * MiB;
constexpr size_t WS_WDT = 504 * MiB;
constexpr float H2_SCALE = 4.0f, W8_SCALE = 64.0f, ACT_SCALE = 4.0f;
constexpr int ACT_ROWS = NTOK * TOPK + NE * 256;
constexpr size_t WS_ACT = 568 * MiB;
constexpr size_t WS_YB = 712 * MiB;
constexpr size_t WS_END = 840 * MiB;
static_assert(WS_ACT + (size_t)ACT_ROWS * 1024 * 2 <= WS_YB, "ACT");

constexpr int CW_TMO = 0;
constexpr int CW_BAR = 4096;
constexpr int CW_ECNT = 16384;

#define LAS __attribute__((address_space(3)))
typedef float f32x4 __attribute__((ext_vector_type(4)));
typedef float f32x2v __attribute__((ext_vector_type(2)));
__device__ __forceinline__ f32x2v mk2(float a, float b) { f32x2v r; r.x = a; r.y = b; return r; }

#define XB_TMO      128
#define XB_XCNT(j)  (256  + 64 * (j))
#define XB_XSUB(j)  (1280 + 64 * (j))
#define XB_XGEN(j)  (2304 + 64 * (j))
#define XB_TOP      3328
#define XB_TOPGEN   3392
#define XCD_BAR_WORDS 3456
#define XB_SPIN_CAP (1u << 18)

__device__ __forceinline__ unsigned xb_ld(unsigned* p)              { return __hip_atomic_load(p, __ATOMIC_RELAXED, __HIP_MEMORY_SCOPE_AGENT); }
__device__ __forceinline__ unsigned xb_add(unsigned* p, unsigned v) { return __hip_atomic_fetch_add(p, v, __ATOMIC_RELAXED, __HIP_MEMORY_SCOPE_AGENT); }
__device__ __forceinline__ unsigned xb_xcc_id() { return (unsigned)__builtin_amdgcn_s_getreg((3 << 11) | 20) & 0xFu; }
#define XB_SPIN(cond, bar) do { unsigned _sp = 0; while (cond) { __builtin_amdgcn_s_sleep(1); \
    if ((++_sp & 255u) == 0u) { if (xb_ld(&(bar)[XB_TMO])) break; if (_sp > XB_SPIN_CAP) { atomicAdd(&(bar)[XB_TMO], 1u); break; } } } } while (0)

struct XcdBarrier { unsigned* bar; unsigned x; volatile LAS unsigned* st; };

__device__ __forceinline__ XcdBarrier xcd_barrier_post(unsigned* bar, volatile LAS unsigned* st) {
    XcdBarrier b; b.bar = bar; b.x = xb_xcc_id(); b.st = st;
    if (threadIdx.x == 0) (void)xb_add(&bar[XB_XCNT(b.x)], 1u);
    return b;
}
__device__ __forceinline__ void xcd_barrier_complete(unsigned* bar, unsigned x, unsigned& nloc, unsigned& nx) {
    const unsigned G = gridDim.x * gridDim.y * gridDim.z;
    unsigned sum, cnt, mine, sp = 0u;
    for (;;) {
        sum = 0u; cnt = 0u; mine = 0u;
#pragma unroll
        for (unsigned j = 0; j < 16; ++j) { const unsigned c = xb_ld(&bar[XB_XCNT(j)]); sum += c; cnt += (c > 0u) ? 1u : 0u; mine = (j == x) ? c : mine; }
        if (sum == G) break;
        __builtin_amdgcn_s_sleep(1);
        if ((++sp & 255u) == 0u) { if (xb_ld(&bar[XB_TMO])) break; if (sp > XB_SPIN_CAP) { atomicAdd(&bar[XB_TMO], 1u); break; } }
    }
    nloc = mine > 0u ? mine : 1u; nx = cnt > 0u ? cnt : 1u;
}
__device__ __forceinline__ void xcd_barrier(const XcdBarrier& b) {
    asm volatile("s_waitcnt vmcnt(0)" ::: "memory");
    __syncthreads();
    if (threadIdx.x == 0) {
        unsigned* bar = b.bar;
        __builtin_amdgcn_s_waitcnt(0);
        unsigned nloc = b.st[0], nx = b.st[1];
        if (nloc == 0u) { xcd_barrier_complete(bar, b.x, nloc, nx); b.st[0] = nloc; b.st[1] = nx; }
        const unsigned old = xb_add(&bar[XB_XSUB(b.x)], 1u);
        const unsigned gen = old / nloc;
        if (old + 1u == (gen + 1u) * nloc) {
            __builtin_amdgcn_fence(__ATOMIC_RELEASE, "agent");
            asm volatile("s_waitcnt vmcnt(0)" ::: "memory");
            const unsigned og = xb_add(&bar[XB_TOP], 1u);
            const unsigned tg = og / nx;
            if (og + 1u == (tg + 1u) * nx) xb_add(&bar[XB_TOPGEN], 1u);
            else XB_SPIN(xb_ld(&bar[XB_TOPGEN]) == tg, bar);
            __builtin_amdgcn_fence(__ATOMIC_ACQUIRE, "agent");
            xb_add(&bar[XB_XGEN(b.x)], 1u);
            asm volatile("s_waitcnt vmcnt(0)" ::: "memory");
        } else {
            XB_SPIN(xb_ld(&bar[XB_XGEN(b.x)]) == gen, bar);
            __builtin_amdgcn_fence(__ATOMIC_ACQUIRE, "agent");
            asm volatile("s_waitcnt vmcnt(0)" ::: "memory");
        }
    }
    __syncthreads();
}


namespace pg8 {
#define PG8_LAS __attribute__((address_space(3)))
typedef unsigned short bf16_t;
typedef short bf16x8 __attribute__((ext_vector_type(8)));
typedef float f32x4 __attribute__((ext_vector_type(4)));
typedef unsigned u32x4 __attribute__((ext_vector_type(4)));
constexpr int BM = 256, BK = 64, HALF = 128, HTB = HALF * BK * 2, STAGE_BYTES = 8 * HTB;

__host__ __device__ __forceinline__ int lds_byte(int r, int c) { const int st = (r >> 4) * 2 + (c >> 5), rr = r & 15, cc = c & 31, ob = rr * 64 + cc * 2; return st * 1024 + (ob ^ (((ob >> 9) & 1) << 5)); }
__host__ __device__ __forceinline__ void stage_rc(int b, int& R, int& C) { const int st = b / 1024, sb = b % 1024, swz = sb ^ (((sb >> 9) & 1) << 5); R = (st >> 1) * 16 + swz / 64; C = (st & 1) * 32 + (swz % 64) / 2; }
__host__ __device__ __forceinline__ int perm32(int rho) { const int n = rho >> 4, i = rho & 15; return 8 * (i >> 2) + 4 * n + (i & 3); }
__device__ __forceinline__ unsigned cvt_pk_bf16(float lo, float hi) { unsigned r; asm volatile("v_cvt_pk_bf16_f32 %0, %1, %2" : "=v"(r) : "v"(lo), "v"(hi)); return r; }

typedef int i32x8 __attribute__((ext_vector_type(8)));
__device__ __forceinline__ i32x8 cat8(const bf16x8& lo, const bf16x8& hi) {
    typedef int i32x4 __attribute__((ext_vector_type(4)));
    const i32x4 a = __builtin_bit_cast(i32x4, lo), b = __builtin_bit_cast(i32x4, hi);
    return __builtin_shufflevector(a, b, 0, 1, 2, 3, 4, 5, 6, 7);
}
__device__ __forceinline__ void mfma_f8(f32x4& c, const i32x8& a, const i32x8& b, int sc) {
    asm volatile("s_nop 1\n\tv_mfma_scale_f32_16x16x128_f8f6f4 %0, %1, %2, %0, %3, %3 op_sel_hi:[0,0,0]" : "+v"(c) : "v"(a), "v"(b), "v"(sc));
}
template <class P, class Epi, bool ALIGN_EPI, bool F8 = false>
__device__ __forceinline__ void gemm_phase(PG8_LAS unsigned char* lds, const P& S, const Epi& E) {
    const int tid = threadIdx.x, wid = __builtin_amdgcn_readfirstlane(tid >> 6), lane = tid & 63, wr = wid >> 2, wc = wid & 3, fr = lane & 15, fq = lane >> 4;
    const int nt = S.nt();
    int Rr[2], Cc[2]; unsigned voffB[2];
#pragma unroll
    for (int i = 0; i < 2; ++i) { int R, C; stage_rc(tid * 16 + i * 8192, R, C); Rr[i] = R; Cc[i] = C; const int Rb = Epi::PERM ? ((R & ~31) + perm32(R & 31)) : R;
        voffB[i] = (unsigned)(Rb * (nt * BK) + C) * 2u; }
    const size_t kstep = (size_t)(BK * 2);
    const size_t hstepB = (size_t)HALF * (nt * BK) * 2;
    const unsigned ldsw = (unsigned)wid * 1024u;
    const int aoff = lds_byte(wr * 64 + fr, fq * 8), boff = lds_byte(wc * 32 + fr, fq * 8);
#define PG8_SA(b, h) (((b) * 2 + (h)) * HTB)
#define PG8_SB(b, h) ((4 + (b) * 2 + (h)) * HTB)
#define PG8_STAGE(bufoff, gbase, voff) do { _Pragma("unroll") for (int _i = 0; _i < 2; ++_i) \
        __builtin_amdgcn_global_load_lds((const unsigned*)((const char*)(gbase) + (voff)[_i]), (PG8_LAS unsigned*)(lds + (bufoff) + ldsw + _i * 8192), 16, 0, 0); } while (0)
#define PG8_LDA(dst, b, h) do { _Pragma("unroll") for (int m = 0; m < 4; ++m) _Pragma("unroll") for (int k = 0; k < 2; ++k) dst[m][k] = *(const PG8_LAS bf16x8*)(lds + PG8_SA(b, h) + aoff + m * 2048 + k * 1024); } while (0)
#define PG8_LDB(dst, b, h) do { _Pragma("unroll") for (int n = 0; n < 2; ++n) _Pragma("unroll") for (int k = 0; k < 2; ++k) dst[n][k] = *(const PG8_LAS bf16x8*)(lds + PG8_SB(b, h) + boff + n * 2048 + k * 1024); } while (0)
#define PG8_MMA(ai, bj, At, Bt) do { __builtin_amdgcn_s_setprio(1); _Pragma("unroll") for (int m = 0; m < 4; ++m) _Pragma("unroll") for (int n = 0; n < 2; ++n) { \
        if constexpr (F8) mfma_f8(acc[ai][bj][m][n], cat8(Bt[n][0], Bt[n][1]), cat8(At[m][0], At[m][1]), f8scale); \
        else { _Pragma("unroll") for (int k = 0; k < 2; ++k) acc[ai][bj][m][n] = __builtin_amdgcn_mfma_f32_16x16x32_bf16(Bt[n][k], At[m][k], acc[ai][bj][m][n], 0, 0, 0); } } \
        __builtin_amdgcn_s_setprio(0); } while (0)
#define PG8_WAIT_V(n) asm volatile("s_waitcnt vmcnt(" #n ")" ::: "memory")
#define PG8_WAIT_L(n) asm volatile("s_waitcnt lgkmcnt(" #n ")" ::: "memory")
#define PG8_BAR __builtin_amdgcn_s_barrier()
#define PG8_SCHED __builtin_amdgcn_sched_barrier(0)
    typename P::U cur, nxt; int ui = 0;
    if (!S.next(0, cur)) return;
    const int f8scale = 0x7f7f7f7f;
    f32x4 acc[2][2][4][2];
#pragma unroll
    for (int a = 0; a < 2; ++a)
#pragma unroll
        for (int b = 0; b < 2; ++b)
#pragma unroll
            for (int m = 0; m < 4; ++m)
#pragma unroll
                for (int n = 0; n < 2; ++n) acc[a][b][m][n] = (f32x4){0.f, 0.f, 0.f, 0.f};
    bf16x8 At[4][2], B0[2][2], B1[2][2];
    unsigned vA[2][2], vN[2][2];
    S.a_off(cur, 0, Rr, Cc, vA);
    const char* cA = S.a_base(cur); const char* cB = S.b_base(cur);
    PG8_STAGE(PG8_SB(0, 0), cB, voffB); PG8_STAGE(PG8_SB(0, 1), cB + hstepB, voffB); PG8_STAGE(PG8_SA(0, 0), cA, vA[0]); PG8_STAGE(PG8_SA(0, 1), cA, vA[1]);
    if (wr == 1) PG8_BAR;
    PG8_WAIT_V(2); PG8_BAR;
    PG8_STAGE(PG8_SB(1, 0), cB + kstep, voffB); PG8_STAGE(PG8_SA(1, 0), cA + kstep, vA[0]); PG8_STAGE(PG8_SB(1, 1), cB + hstepB + kstep, voffB);
    PG8_WAIT_V(6); PG8_BAR;
    for (;;) {
        const bool has_next = S.next(ui + 1, nxt);
        const char* nA = cA; const char* nB = cB;
#pragma unroll
        for (int h = 0; h < 2; ++h)
#pragma unroll
            for (int i = 0; i < 2; ++i) vN[h][i] = vA[h][i];
        if (has_next) { nA = S.a_base(nxt); nB = S.b_base(nxt); S.a_off(nxt, ui + 1, Rr, Cc, vN); }
#pragma unroll 1
        for (int t = 0; t < nt; t += 2) {
            const bool last = (t == nt - 2);
            const char* a1 = cA + (size_t)(t + 1) * kstep;
            const char* a2 = last ? nA : cA + (size_t)(t + 2) * kstep; const char* b2 = last ? nB : cB + (size_t)(t + 2) * kstep;
            const char* a3 = a2 + kstep; const char* b3 = b2 + kstep;
            unsigned vX[2][2];
#pragma unroll
            for (int h = 0; h < 2; ++h)
#pragma unroll
                for (int i = 0; i < 2; ++i) vX[h][i] = last ? vN[h][i] : vA[h][i];
            PG8_LDB(B0, 0, 0); PG8_LDB(B1, 0, 1); PG8_SCHED; PG8_LDA(At, 0, 0); PG8_STAGE(PG8_SA(1, 1), a1, vA[1]);
            PG8_WAIT_V(8); PG8_WAIT_L(0); PG8_BAR; PG8_MMA(0, 0, At, B0); PG8_MMA(0, 1, At, B1); PG8_BAR; PG8_SCHED;
            PG8_LDA(At, 0, 1); PG8_STAGE(PG8_SB(0, 0), b2, voffB); PG8_STAGE(PG8_SB(0, 1), b2 + hstepB, voffB); PG8_STAGE(PG8_SA(0, 0), a2, vX[0]);
            PG8_WAIT_V(8); PG8_WAIT_L(0); PG8_BAR; PG8_MMA(1, 0, At, B0); PG8_MMA(1, 1, At, B1); PG8_BAR; PG8_SCHED;
            PG8_LDB(B0, 1, 0); PG8_LDB(B1, 1, 1); PG8_SCHED; PG8_LDA(At, 1, 0); PG8_STAGE(PG8_SA(0, 1), a2, vX[1]);
            PG8_WAIT_V(8); PG8_WAIT_L(0); PG8_BAR; PG8_MMA(0, 0, At, B0); PG8_MMA(0, 1, At, B1); PG8_BAR; PG8_SCHED;
            PG8_LDA(At, 1, 1); PG8_STAGE(PG8_SB(1, 0), b3, voffB); PG8_STAGE(PG8_SB(1, 1), b3 + hstepB, voffB); PG8_STAGE(PG8_SA(1, 0), a3, vX[0]);
            PG8_WAIT_V(8); PG8_WAIT_L(0); PG8_BAR; PG8_MMA(1, 0, At, B0); PG8_MMA(1, 1, At, B1); PG8_BAR; PG8_SCHED;
        }
        if constexpr (ALIGN_EPI) { if (wr == 0) PG8_BAR; }
        if constexpr (F8) asm volatile("s_nop 15\n\ts_nop 7" ::: "memory");
        E(acc, cur, ui, wr, wc, fr, fq);
        if (!has_next) break;
#pragma unroll
        for (int a = 0; a < 2; ++a)
#pragma unroll
            for (int b = 0; b < 2; ++b)
#pragma unroll
                for (int m = 0; m < 4; ++m)
#pragma unroll
                    for (int n = 0; n < 2; ++n) acc[a][b][m][n] = (f32x4){0.f, 0.f, 0.f, 0.f};
        cur = nxt; cA = nA; cB = nB; ++ui;
#pragma unroll
        for (int h = 0; h < 2; ++h)
#pragma unroll
            for (int i = 0; i < 2; ++i) vA[h][i] = vN[h][i];
        if constexpr (ALIGN_EPI) { if (wr == 1) PG8_BAR; }
    }
    PG8_WAIT_V(0);
    if constexpr (!ALIGN_EPI) { if (wr == 0) PG8_BAR; }
    PG8_BAR;
#undef PG8_SA
#undef PG8_SB
#undef PG8_STAGE
#undef PG8_LDA
#undef PG8_LDB
#undef PG8_MMA
#undef PG8_WAIT_V
#undef PG8_WAIT_L
#undef PG8_BAR
#undef PG8_SCHED
}
}
typedef unsigned short bf16;
typedef unsigned v4u __attribute__((ext_vector_type(4)));
__device__ __forceinline__ unsigned f2bf(float f) { unsigned u = __builtin_bit_cast(unsigned, f); return (u + 0x7fffu + ((u >> 16) & 1u)) >> 16; }
__device__ __forceinline__ unsigned pk2(float lo, float hi) { return f2bf(lo) | (f2bf(hi) << 16); }
__device__ __forceinline__ float bf_lo(unsigned u) { return __builtin_bit_cast(float, u << 16); }
__device__ __forceinline__ float bf_hi(unsigned u) { return __builtin_bit_cast(float, u & 0xffff0000u); }
constexpr int XTRA_OFF = 131072 + 512;
constexpr int MAXU = 12;
constexpr int XT_ROWT = XTRA_OFF;
constexpr int XT_UNITS = XT_ROWT + MAXU * 1024;
constexpr int XT_TP = XT_UNITS + MAXU * 16;
static_assert(XT_TP + 40 * 4 <= LDS_BYTES, "LDS map");

struct Frame {
    unsigned char* lds;
    LAS unsigned char* ldsl;
    int tid, lane, wave, bid, G;
    const float* in[29];
    float* out;
    unsigned char* ws;
    unsigned* ctl;
};
enum { I_X = 0, I_C, I_WADA, I_BADA, I_GPRE, I_WIN, I_SINK, I_ARE, I_AIM, I_LOGDT, I_BRE, I_BIM, I_CRE, I_CIM, I_DSK, I_WGLU, I_BGLU,
       I_GATT, I_GSSM, I_WOUT, I_GPOST, I_GPREF, I_WR, I_BR, I_WGU, I_BGU, I_WD, I_BD, I_GPOSTF };

__device__ __forceinline__ float wave_sum(float v) {
#pragma unroll
    for (int o = 1; o < 64; o <<= 1) v += __shfl_xor(v, o);
    return v;
}
__device__ __forceinline__ float wave_max(float v) {
#pragma unroll
    for (int o = 1; o < 64; o <<= 1) v = fmaxf(v, __shfl_xor(v, o));
    return v;
}
__device__ __forceinline__ float fast_sigmoid(float x) { return __builtin_amdgcn_rcpf(1.0f + __builtin_amdgcn_exp2f(-1.4426950408889634f * x)); }
__device__ __forceinline__ float sigmoidf_(float x) { return 1.0f / (1.0f + expf(-x)); }
__device__ __forceinline__ float gelu_tanh(float x) { const float u = 0.7978845608028654f * (x + 0.044715f * x * x * x); return 0.5f * x * (1.0f + tanhf(u)); }

__device__ __forceinline__ void row_load(const float* row, int lane, f32x4 (&v)[4]) {
#pragma unroll
    for (int j = 0; j < 4; ++j) v[j] = *(const f32x4*)(row + (j * 64 + lane) * 4);
}
__device__ __forceinline__ void row_store(float* row, int lane, const f32x4 (&v)[4]) {
#pragma unroll
    for (int j = 0; j < 4; ++j) *(f32x4*)(row + (j * 64 + lane) * 4) = v[j];
}
__device__ __forceinline__ float row_sumsq(const f32x4 (&v)[4]) {
    float s = 0.f;
#pragma unroll
    for (int j = 0; j < 4; ++j) s += v[j].x * v[j].x + v[j].y * v[j].y + v[j].z * v[j].z + v[j].w * v[j].w;
    return wave_sum(s);
}

template <int MODE>
__device__ __forceinline__ void naive_tile(Frame& F, const float* A, int lda, const int* list, int nvalid, int m0,
                                           const float* B, int ldb, int n0, int K, float* C, int ldc, const float* bias) {
    float* As = (float*)F.lds;
    float* Bs = As + 16 * 132;
    float* Bs2 = Bs + 16 * 68;
    const int tid = F.tid, tm = tid >> 4, tn = tid & 15;
    float acc[4][4], acc2[4][4];
#pragma unroll
    for (int i = 0; i < 4; ++i)
#pragma unroll
        for (int j = 0; j < 4; ++j) { acc[i][j] = 0.f; acc2[i][j] = 0.f; }
    const int ar = tid >> 2, ak = (tid & 3) * 4;
    const float* arow = nullptr;
    {
        const int r = m0 + ar;
        if (MODE == 0) arow = A + (size_t)r * lda;
        else if (r < nvalid) { const int a = list[r]; arow = A + (size_t)(MODE == 1 ? (a >> 2) : a) * lda; }
    }
    const int bk = (tid & 255) >> 4, bn = (tid & 15) * 4;
    for (int k0 = 0; k0 < K; k0 += 16) {
        f32x4 av = (f32x4){0.f, 0.f, 0.f, 0.f};
        if (arow) av = *(const f32x4*)(arow + k0 + ak);
        f32x4 bv = (f32x4){0.f, 0.f, 0.f, 0.f};
        if (tid < 256) bv = *(const f32x4*)(B + (size_t)(k0 + bk) * ldb + n0 + bn);
        else if (MODE == 1) bv = *(const f32x4*)(B + (size_t)(k0 + bk) * ldb + n0 + DFF + bn);
        __syncthreads();
        As[(ak + 0) * 132 + ar] = av.x; As[(ak + 1) * 132 + ar] = av.y; As[(ak + 2) * 132 + ar] = av.z; As[(ak + 3) * 132 + ar] = av.w;
        if (tid < 256) *(f32x4*)(Bs + bk * 68 + bn) = bv;
        else if (MODE == 1) *(f32x4*)(Bs2 + bk * 68 + bn) = bv;
        __syncthreads();
#pragma unroll
        for (int k = 0; k < 16; ++k) {
            const f32x4 a4 = *(const f32x4*)(As + k * 132 + tm * 4);
            const f32x4 b4 = *(const f32x4*)(Bs + k * 68 + tn * 4);
            const float a_[4] = {a4.x, a4.y, a4.z, a4.w}, b_[4] = {b4.x, b4.y, b4.z, b4.w};
#pragma unroll
            for (int i = 0; i < 4; ++i)
#pragma unroll
                for (int j = 0; j < 4; ++j) acc[i][j] += a_[i] * b_[j];
            if (MODE == 1) {
                const f32x4 c4 = *(const f32x4*)(Bs2 + k * 68 + tn * 4);
                const float c_[4] = {c4.x, c4.y, c4.z, c4.w};
#pragma unroll
                for (int i = 0; i < 4; ++i)
#pragma unroll
                    for (int j = 0; j < 4; ++j) acc2[i][j] += a_[i] * c_[j];
            }
        }
    }
#pragma unroll
    for (int i = 0; i < 4; ++i) {
        const int r = m0 + tm * 4 + i;
        if (MODE != 0 && r >= nvalid) continue;
        const size_t orow = (MODE == 0) ? (size_t)r : (size_t)list[r];
        f32x4 o;
        float ov[4];
#pragma unroll
        for (int j = 0; j < 4; ++j) {
            const int n = n0 + tn * 4 + j;
            if (MODE == 0) ov[j] = acc[i][j];
            else if (MODE == 1) {
                float glu = acc[i][j] + bias[n], lin = acc2[i][j] + bias[n + DFF];
                glu = fminf(glu, 7.0f); lin = fminf(fmaxf(lin, -7.0f), 7.0f);
                ov[j] = glu * sigmoidf_(1.702f * glu) * (lin + 1.0f);
            } else ov[j] = acc[i][j] + bias[n];
        }
        o.x = ov[0]; o.y = ov[1]; o.z = ov[2]; o.w = ov[3];
        *(f32x4*)(C + orow * ldc + n0 + tn * 4) = o;
    }
    __syncthreads();
}

__device__ __forceinline__ void naive_gemm_plain(Frame& F, const float* A, int lda, const float* B, int ldb, float* C, int ldc, int M, int N, int K) {
    const int nM = M / 128, nN = N / 64;
    for (int t = F.bid; t < nM * nN; t += F.G) {
        const int tmi = t / nN, tni = t % nN;
        naive_tile<0>(F, A, lda, nullptr, 0, tmi * 128, B, ldb, tni * 64, K, C, ldc, nullptr);
    }
}

__device__ __forceinline__ unsigned pk4_fp8(float a, float b, float c, float d) {
    a = fminf(fmaxf(a, -448.f), 448.f); b = fminf(fmaxf(b, -448.f), 448.f); c = fminf(fmaxf(c, -448.f), 448.f); d = fminf(fmaxf(d, -448.f), 448.f);
    int p = __builtin_amdgcn_cvt_pk_fp8_f32(a, b, 0, false);
    p = __builtin_amdgcn_cvt_pk_fp8_f32(c, d, p, true);
    return (unsigned)p;
}
__device__ __forceinline__ void ssm_tables(struct Frame& F, int g);
__device__ __forceinline__ void ph_mods(Frame& F) {
    float* sc = (float*)F.lds;
    float* red = sc + 4096;
    float* mods = (float*)(F.ws + WS_MODS);
    const float* c = F.in[I_C]; const float* w = F.in[I_WADA]; const float* bb = F.in[I_BADA];
    for (int it = F.bid; it < NMOD / 256 + NG; it += F.G) {
        if (it >= NMOD / 256) { ssm_tables(F, it - NMOD / 256); continue; }
        const int cg = it;
        __syncthreads();
        for (int i = F.tid; i < 4096; i += NTHR) { const float v = c[i]; sc[i] = v / (1.0f + expf(-v)); }
        __syncthreads();
        f32x4 acc[4];
#pragma unroll
        for (int b = 0; b < 4; ++b) acc[b] = (f32x4){0.f, 0.f, 0.f, 0.f};
        const int kb = F.wave * 128;
        for (int k = kb; k < kb + 128; ++k) {
            const f32x4 wv = *(const f32x4*)(w + (size_t)k * NMOD + cg * 256 + F.lane * 4);
#pragma unroll
            for (int b = 0; b < 4; ++b) acc[b] += sc[b * 1024 + k] * wv;
        }
#pragma unroll
        for (int b = 0; b < 4; ++b) *(f32x4*)(red + ((F.wave * 4 + b) * 256 + F.lane * 4)) = acc[b];
        __syncthreads();
        for (int i = F.tid; i < 1024; i += NTHR) {
            const int b = i >> 8, col = i & 255;
            float s = 0.f;
#pragma unroll
            for (int wv = 0; wv < 8; ++wv) s += red[(wv * 4 + b) * 256 + col];
            mods[b * NMOD + cg * 256 + col] = s + bb[cg * 256 + col];
        }
    }
    __syncthreads();
}

__device__ __forceinline__ void ph_h1(Frame& F) {
    const float* mods = (const float*)(F.ws + WS_MODS);
    bf16* H = (bf16*)(F.ws + WS_H1B);
    const float* g = F.in[I_GPRE];
    for (int row = F.bid * NWAVES + F.wave; row < NTOK; row += F.G * NWAVES) {
        const int b = row / SEQ;
        f32x4 v[4]; row_load(F.in[I_X] + (size_t)row * DM, F.lane, v);
        const float rstd = rsqrtf(row_sumsq(v) * (1.0f / DM) + RMS_EPS);
#pragma unroll
        for (int j = 0; j < 4; ++j) {
            const int c0 = (j * 64 + F.lane) * 4;
            const f32x4 gg = *(const f32x4*)(g + c0), sh = *(const f32x4*)(mods + b * NMOD + c0), scv = *(const f32x4*)(mods + b * NMOD + DM + c0);
            v[j] = v[j] * rstd * gg * (1.0f + scv) + sh;
            uint2 w; w.x = pk2(v[j].x, v[j].y); w.y = pk2(v[j].z, v[j].w); *(uint2*)(H + (size_t)row * DM + c0) = w;
        }
    }
}

typedef float f32x16 __attribute__((ext_vector_type(16)));
constexpr int AT_KS = 0, AT_KSTRIDE = 144, AT_VT = 384 * AT_KSTRIDE, AT_VSTRIDE = 792;
static_assert(AT_VT + 64 * AT_VSTRIDE <= 131072, "attention LDS");
__device__ __forceinline__ void ph_attn(Frame& F) {
    const bf16* P = (const bf16*)(F.ws + WS_PROJB);
    bf16* O = (bf16*)(F.ws + WS_ATTB);
    LAS unsigned char* l = F.ldsl;
    const int lane = F.lane, c = lane & 31, hh = lane >> 5, g = F.wave & 3, th = F.wave >> 2;
    for (int unit = F.bid; unit < BATCH * (SEQ / 128) * NKVH; unit += F.G) {
        const int kvh = unit & 1, nb = (unit >> 1) & 31, b = unit >> 6;
        const int tok0 = nb * 128 - 128;
        __syncthreads();
#pragma unroll
        for (int i = 0; i < 6; ++i) {
            const int idx = F.tid + 512 * i, row = idx >> 3, c16 = idx & 7, pos = tok0 + row;
            v4u w = (v4u){0u, 0u, 0u, 0u};
            if (pos >= 0 && pos < SEQ) w = *(const v4u*)(P + (size_t)(b * SEQ + pos) * INW + COL_K + kvh * 64 + c16 * 8);
            *(LAS v4u*)(l + AT_KS + row * AT_KSTRIDE + c16 * 16) = w;
        }
#pragma unroll
        for (int i = 0; i < 3; ++i) {
            const int idx = F.tid + 512 * i, r2 = idx >> 3, c16 = idx & 7, pos = tok0 + 2 * r2;
            v4u w0 = (v4u){0u, 0u, 0u, 0u}, w1 = w0;
            if (pos >= 0 && pos < SEQ) { const bf16* vp = P + (size_t)(b * SEQ + pos) * INW + COL_V + kvh * 64 + c16 * 8; w0 = *(const v4u*)vp; w1 = *(const v4u*)(vp + INW); }
            const unsigned a0[4] = {w0.x, w0.y, w0.z, w0.w}, a1[4] = {w1.x, w1.y, w1.z, w1.w};
#pragma unroll
            for (int q = 0; q < 4; ++q) {
                const unsigned lo = (a0[q] & 0xffffu) | (a1[q] << 16), hi = (a0[q] >> 16) | (a1[q] & 0xffff0000u);
                *(LAS unsigned*)(l + AT_VT + (c16 * 8 + 2 * q) * AT_VSTRIDE + r2 * 4) = lo;
                *(LAS unsigned*)(l + AT_VT + (c16 * 8 + 2 * q + 1) * AT_VSTRIDE + r2 * 4) = hi;
            }
        }
        const int qh = kvh * 4 + g;
        const float sinkv = F.in[I_SINK][qh] * 1.4426950408889634f;
        __syncthreads();
#pragma unroll 1
        for (int qt = 0; qt < 2; ++qt) {
            const int qrel = 128 + th * 64 + qt * 32 + c;
            pg8::bf16x8 qf[4];
#pragma unroll
            for (int ks = 0; ks < 4; ++ks)
                qf[ks] = *(const pg8::bf16x8*)(P + (size_t)(b * SEQ + nb * 128 + th * 64 + qt * 32 + c) * INW + qh * 64 + ks * 16 + hh * 8);
            float m_run = sinkv, l_run = hh == 0 ? 1.0f : 0.0f;
            f32x16 o0, o1;
#pragma unroll
            for (int j = 0; j < 16; ++j) { o0[j] = 0.f; o1[j] = 0.f; }
            const int kt0 = th * 2 + qt;
#pragma unroll 1
            for (int kk = 0; kk < 9; ++kk) {
                const int kt = kt0 + kk;
                f32x16 s;
#pragma unroll
                for (int j = 0; j < 16; ++j) s[j] = 0.f;
#pragma unroll
                for (int ks = 0; ks < 4; ++ks) {
                    const pg8::bf16x8 kf = *(const LAS pg8::bf16x8*)(l + AT_KS + (kt * 32 + c) * AT_KSTRIDE + ks * 32 + hh * 16);
                    s = __builtin_amdgcn_mfma_f32_32x32x16_bf16(kf, qf[ks], s, 0, 0, 0);
                }
                const bool edge = (kk == 0) || (kk == 8) || (nb == 0) || (nb == SEQ / 128 - 1);
                float mx = -3.0e38f;
#pragma unroll
                for (int j = 0; j < 16; ++j) {
                    float v = s[j] * 1.4426950408889634f;
                    if (edge) {
                        const int krel = kt * 32 + (j & 3) + 8 * (j >> 2) + 4 * hh, d = qrel - krel, pos = tok0 + krel;
                        const bool ok = (d <= WIN) && (d >= -WIN) && (pos >= 0) && (pos < SEQ);
                        v = ok ? v : -1.0e30f;
                    }
                    s[j] = v; mx = fmaxf(mx, v);
                }
                mx = fmaxf(mx, __shfl_xor(mx, 32));
                const float m_new = fmaxf(m_run, mx), corr = __builtin_amdgcn_exp2f(m_run - m_new);
                m_run = m_new;
                float ps = 0.f;
#pragma unroll
                for (int j = 0; j < 16; ++j) { s[j] = __builtin_amdgcn_exp2f(s[j] - m_new); ps += s[j]; }
                l_run = l_run * corr + ps;
#pragma unroll
                for (int j = 0; j < 16; ++j) { o0[j] *= corr; o1[j] *= corr; }
#pragma unroll
                for (int st = 0; st < 2; ++st) {
                    typedef unsigned u32x4v __attribute__((ext_vector_type(4)));
                    u32x4v pw;
                    pw.x = pg8::cvt_pk_bf16(s[8 * st + 0], s[8 * st + 1]); pw.y = pg8::cvt_pk_bf16(s[8 * st + 2], s[8 * st + 3]);
                    pw.z = pg8::cvt_pk_bf16(s[8 * st + 4], s[8 * st + 5]); pw.w = pg8::cvt_pk_bf16(s[8 * st + 6], s[8 * st + 7]);
                    const pg8::bf16x8 pf = __builtin_bit_cast(pg8::bf16x8, pw);
                    const int kb = (kt * 32 + 16 * st + 4 * hh) * 2;
#pragma unroll
                    for (int dt = 0; dt < 2; ++dt) {
                        typedef unsigned u32x2v __attribute__((ext_vector_type(2)));
                        const u32x2v v0 = *(const LAS u32x2v*)(l + AT_VT + (dt * 32 + c) * AT_VSTRIDE + kb);
                        const u32x2v v1 = *(const LAS u32x2v*)(l + AT_VT + (dt * 32 + c) * AT_VSTRIDE + kb + 16);
                        u32x4v vw; vw.x = v0.x; vw.y = v0.y; vw.z = v1.x; vw.w = v1.y;
                        const pg8::bf16x8 vf = __builtin_bit_cast(pg8::bf16x8, vw);
                        if (dt == 0) o0 = __builtin_amdgcn_mfma_f32_32x32x16_bf16(vf, pf, o0, 0, 0, 0);
                        else o1 = __builtin_amdgcn_mfma_f32_32x32x16_bf16(vf, pf, o1, 0, 0, 0);
                    }
                }
            }
            const float lt = l_run + __shfl_xor(l_run, 32), inv = 1.0f / lt;
            bf16* orow = O + (size_t)(b * SEQ + nb * 128 + th * 64 + qt * 32 + c) * AW + qh * 64;
#pragma unroll
            for (int q = 0; q < 4; ++q) {
                uint2 w; w.x = pk2(o0[4 * q] * inv, o0[4 * q + 1] * inv); w.y = pk2(o0[4 * q + 2] * inv, o0[4 * q + 3] * inv);
                *(uint2*)(orow + 8 * q + 4 * hh) = w;
                w.x = pk2(o1[4 * q] * inv, o1[4 * q + 1] * inv); w.y = pk2(o1[4 * q + 2] * inv, o1[4 * q + 3] * inv);
                *(uint2*)(orow + 32 + 8 * q + 4 * hh) = w;
            }
        }
    }
    __syncthreads();
}

constexpr int TCH = 32, NCH = SEQ / TCH, NRR = BATCH * NCH;
constexpr int UK = 768, UK_U = 512;
__device__ __forceinline__ void ssm_tables(Frame& F, int g) {
    LAS f32x2v* BB = (LAS f32x2v*)(F.ldsl);
    LAS f32x2v* PW = (LAS f32x2v*)(F.ldsl + 16384);
    LAS f32x2v* CC = (LAS f32x2v*)(F.ldsl + 16384 + 33792);
    LAS bf16* KT = (LAS bf16*)(F.ldsl + 16384 + 33792 + 16384);
    bf16* WE = (bf16*)(F.ws + WS_WE) + (size_t)g * 256 * 512;
    bf16* WY = (bf16*)(F.ws + WS_WY) + (size_t)g * 512 * UK;
    __syncthreads();
    if (F.tid < 128) {
        const int dir = F.tid >> 6, p = F.tid & 63, pi = (dir * NG + g) * PST + p;
        const float a_re = F.in[I_ARE][pi], a_im = F.in[I_AIM][pi];
        const float dt = expf(F.in[I_LOGDT][dir * NG + g]);
        const float lr = a_re * dt, li = a_im * dt, mag = expf(lr);
        const float abr = mag * cosf(li), abi = mag * sinf(li);
        const float den = a_re * a_re + a_im * a_im, nr = abr - 1.0f, ni = abi;
        const float f_r = (nr * a_re + ni * a_im) / den, f_i = (ni * a_re - nr * a_im) / den;
        for (int h = 0; h < 16; ++h) {
            const float br = F.in[I_BRE][(size_t)pi * CH + h], bi = F.in[I_BIM][(size_t)pi * CH + h];
            BB[(dir * 64 + p) * 16 + h] = mk2(f_r * br - f_i * bi, f_r * bi + f_i * br);
        }
        for (int n = 0; n <= 32; ++n) { const float mg = expf(lr * (float)n), an = li * (float)n; PW[(dir * 64 + p) * 33 + n] = mk2(mg * cosf(an), mg * sinf(an)); }
    }
    for (int i = F.tid; i < 2048; i += NTHR) {
        const int dir = i >> 10, r = i & 1023;
        CC[i] = mk2(F.in[I_CRE][(size_t)(dir * NG + g) * CH * PST + r], F.in[I_CIM][(size_t)(dir * NG + g) * CH * PST + r]);
    }
    __syncthreads();
    for (int v = F.tid; v < 256 * 64; v += NTHR) {
        const int n = v >> 6, k8 = v & 63, dir = n >> 7, p = (n >> 1) & 63, ri = n & 1, j = k8 >> 1, h0 = (k8 & 1) * 8;
        const f32x2v pw = PW[(dir * 64 + p) * 33 + (dir ? j : 31 - j)];
        float o[8];
#pragma unroll
        for (int q = 0; q < 8; ++q) { const f32x2v bq = BB[(dir * 64 + p) * 16 + h0 + q]; o[q] = ri ? (pw.x * bq.y + pw.y * bq.x) : (pw.x * bq.x - pw.y * bq.y); }
        v4u w; w.x = pk2(o[0], o[1]); w.y = pk2(o[2], o[3]); w.z = pk2(o[4], o[5]); w.w = pk2(o[6], o[7]);
        *(v4u*)(WE + (size_t)n * 512 + k8 * 8) = w;
    }
    for (int v = F.tid; v < 512 * 32; v += NTHR) {
        const int row = v >> 5, c8 = v & 31, i = row >> 4, h = row & 15, dir = c8 >> 4, p0 = (c8 & 15) * 4;
        float o[8];
#pragma unroll
        for (int q = 0; q < 4; ++q) {
            const f32x2v cq = CC[(dir * 16 + h) * 64 + p0 + q], pw = PW[(dir * 64 + p0 + q) * 33 + (dir ? 32 - i : i + 1)];
            o[2 * q] = cq.x * pw.x - cq.y * pw.y; o[2 * q + 1] = -(cq.x * pw.y + cq.y * pw.x);
        }
        v4u w; w.x = pk2(o[0], o[1]); w.y = pk2(o[2], o[3]); w.z = pk2(o[4], o[5]); w.w = pk2(o[6], o[7]);
        *(v4u*)(WY + (size_t)row * UK + UK_U + c8 * 8) = w;
    }
    for (int e = F.tid; e < 63 * 256; e += NTHR) {
        const int ti = e >> 8, h = (e >> 4) & 15, hi = e & 15, tau = ti - 31, at = tau < 0 ? -tau : tau;
        float acc = 0.f;
        if (tau >= 0) for (int p = 0; p < 64; ++p) { const f32x2v cq = CC[h * 64 + p], pw = PW[p * 33 + at], bq = BB[p * 16 + hi];
            const float mr = cq.x * pw.x - cq.y * pw.y, mi = cq.x * pw.y + cq.y * pw.x; acc += mr * bq.x - mi * bq.y; }
        if (tau <= 0) for (int p = 0; p < 64; ++p) { const f32x2v cq = CC[(16 + h) * 64 + p], pw = PW[(64 + p) * 33 + at], bq = BB[(64 + p) * 16 + hi];
            const float mr = cq.x * pw.x - cq.y * pw.y, mi = cq.x * pw.y + cq.y * pw.x; acc += mr * bq.x - mi * bq.y; }
        if (tau == 0 && h == hi) acc += F.in[I_DSK][g * CH + h];
        KT[e] = (bf16)f2bf(acc);
    }
    __syncthreads();
    for (int v = F.tid; v < 512 * 64; v += NTHR) {
        const int row = v >> 6, k8 = v & 63, i = row >> 4, h = row & 15, j = k8 >> 1, hi0 = (k8 & 1) * 8;
        *(v4u*)(WY + (size_t)row * UK + k8 * 8) = *(const LAS v4u*)(KT + ((i - j + 31) * 16 + h) * 16 + hi0);
    }
    __syncthreads();
}

struct GrpUnit { int g, pm, pn; };
struct GrpProb {
    typedef GrpUnit U;
    const char* A; const char* B; size_t a_gs, b_gs; int lda_b; int K; int nN, total, G, vb;
    __device__ __forceinline__ int nt() const { return K / 64; }
    __device__ __forceinline__ bool next(int i, U& u) const { const int L = i * G + vb; if (L >= total) return false; u.g = L / (2 * nN); const int r = L % (2 * nN); u.pm = r / nN; u.pn = r % nN; return true; }
    __device__ __forceinline__ const char* a_base(const U& u) const { return A + u.g * a_gs + (size_t)u.pm * 256 * lda_b; }
    __device__ __forceinline__ const char* b_base(const U& u) const { return B + u.g * b_gs + (size_t)u.pn * 256 * K * 2; }
    __device__ __forceinline__ void a_off(const U&, int, const int (&R)[2], const int (&C)[2], unsigned (&v)[2][2]) const {
#pragma unroll
        for (int h = 0; h < 2; ++h)
#pragma unroll
            for (int i = 0; i < 2; ++i) v[h][i] = (unsigned)((h * 128 + R[i]) * lda_b + C[i] * 2);
    }
};
struct EpiEst {
    static constexpr bool PERM = false;
    float* EST;
    __device__ __forceinline__ void operator()(const pg8::f32x4 (&acc)[2][2][4][2], const GrpUnit& u, int, int wr, int wc, int fr, int fq) const {
#pragma unroll
        for (int ai = 0; ai < 2; ++ai)
#pragma unroll
            for (int m = 0; m < 4; ++m) {
                float* rowp = EST + ((size_t)u.g * NRR + u.pm * 256 + ai * 128 + wr * 64 + m * 16 + fr) * 256 + wc * 32 + 4 * fq;
#pragma unroll
                for (int bj = 0; bj < 2; ++bj)
#pragma unroll
                    for (int n = 0; n < 2; ++n) *(f32x4*)(rowp + bj * 128 + n * 16) = acc[ai][bj][m][n];
            }
    }
};
__device__ __forceinline__ float fast_gelu_tanh(float x) {
    const float u = 0.7978845608028654f * (x + 0.044715f * x * x * x);
    const float t = 1.0f - 2.0f * __builtin_amdgcn_rcpf(__builtin_amdgcn_exp2f(2.885390081777927f * u) + 1.0f);
    return 0.5f * x * (1.0f + t);
}
struct EpiSsmY {
    static constexpr bool PERM = true;
    bf16* Gb;
    __device__ __forceinline__ void operator()(const pg8::f32x4 (&acc)[2][2][4][2], const GrpUnit& u, int, int wr, int wc, int fr, int fq) const {
#pragma unroll
        for (int ai = 0; ai < 2; ++ai)
#pragma unroll
            for (int m = 0; m < 4; ++m) {
                const int rr = u.pm * 256 + ai * 128 + wr * 64 + m * 16 + fr, b = rr >> 7, ch = rr & 127;
#pragma unroll
                for (int bj = 0; bj < 2; ++bj) {
                    const int n0 = u.pn * 256 + bj * 128 + wc * 32 + 8 * fq, i = n0 >> 4, h0 = n0 & 15;
                    const f32x4 v0 = acc[ai][bj][m][0], v1 = acc[ai][bj][m][1];
                    v4u w; w.x = pk2(fast_gelu_tanh(v0[0]), fast_gelu_tanh(v0[1])); w.y = pk2(fast_gelu_tanh(v0[2]), fast_gelu_tanh(v0[3]));
                    w.z = pk2(fast_gelu_tanh(v1[0]), fast_gelu_tanh(v1[1])); w.w = pk2(fast_gelu_tanh(v1[2]), fast_gelu_tanh(v1[3]));
                    *(v4u*)(Gb + (size_t)(b * SEQ + ch * TCH + i) * SW + u.g * CH + h0) = w;
                }
            }
    }
};
__device__ __forceinline__ void ph_scan(Frame& F) {
    const float* EST = (const float*)(F.ws + WS_EST);
    bf16* UC = (bf16*)(F.ws + WS_UCAT);
    const int item = F.bid + F.G * F.wave;
    if (item >= BATCH * NG * 2) return;
    const int dir = item & 1, g = (item >> 1) & 31, b = item >> 6, p = F.lane;
    const int pi = (dir * NG + g) * PST + p;
    const float dt = expf(F.in[I_LOGDT][dir * NG + g]);
    const float lr = F.in[I_ARE][pi] * dt * (float)TCH, li = F.in[I_AIM][pi] * dt * (float)TCH, mg = expf(lr);
    const float ar = mg * cosf(li), ai = mg * sinf(li);
    const float* e0 = EST + ((size_t)g * NRR + b * NCH) * 256 + dir * 128 + p * 2;
    bf16* s0 = UC + ((size_t)g * NRR + b * NCH) * UK + UK_U + dir * 128 + p * 2;
    float sr = 0.f, si = 0.f;
    for (int cb = 0; cb < NCH; cb += 32) {
        float2 e[32];
#pragma unroll
        for (int q = 0; q < 32; ++q) { const int c = dir ? NCH - 1 - (cb + q) : cb + q; e[q] = *(const float2*)(e0 + (size_t)c * 256); }
#pragma unroll
        for (int q = 0; q < 32; ++q) {
            const int c = dir ? NCH - 1 - (cb + q) : cb + q;
            *(unsigned*)(s0 + (size_t)c * UK) = pk2(sr, si);
            const float nr = ar * sr - ai * si + e[q].x, ni = ar * si + ai * sr + e[q].y;
            sr = nr; si = ni;
        }
    }
}

__device__ __forceinline__ void ph_cat(Frame& F) {
    const bf16* YS = (const bf16*)(F.ws + WS_YSB);
    const bf16* AT = (const bf16*)(F.ws + WS_ATTB); bf16* YC = (bf16*)(F.ws + WS_YCATB);
    for (int row = F.bid * NWAVES + F.wave; row < NTOK; row += F.G * NWAVES) {
        f32x4 a[2], s[2];
        float sa = 0.f, ss = 0.f;
#pragma unroll
        for (int j = 0; j < 2; ++j) {
            const int c0 = (j * 64 + F.lane) * 4;
            const uint2 wa = *(const uint2*)(AT + (size_t)row * AW + c0);
            a[j] = (f32x4){bf_lo(wa.x), bf_hi(wa.x), bf_lo(wa.y), bf_hi(wa.y)};
            const uint2 w = *(const uint2*)(YS + (size_t)row * SW + c0);
            s[j] = (f32x4){bf_lo(w.x), bf_hi(w.x), bf_lo(w.y), bf_hi(w.y)};
            sa += a[j].x * a[j].x + a[j].y * a[j].y + a[j].z * a[j].z + a[j].w * a[j].w;
            ss += s[j].x * s[j].x + s[j].y * s[j].y + s[j].z * s[j].z + s[j].w * s[j].w;
        }
        const float ra = rsqrtf(wave_sum(sa) * (1.0f / AW) + RMS_EPS), rs = rsqrtf(wave_sum(ss) * (1.0f / SW) + RMS_EPS);
#pragma unroll
        for (int j = 0; j < 2; ++j) {
            const int c0 = (j * 64 + F.lane) * 4;
            const f32x4 oa = a[j] * ra * *(const f32x4*)(F.in[I_GATT] + c0), os = s[j] * rs * *(const f32x4*)(F.in[I_GSSM] + c0);
            uint2 w; w.x = pk2(oa.x, oa.y); w.y = pk2(oa.z, oa.w); *(uint2*)(YC + (size_t)row * DM + c0) = w;
            w.x = pk2(os.x, os.y); w.y = pk2(os.z, os.w); *(uint2*)(YC + (size_t)row * DM + AW + c0) = w;
        }
    }
}

__device__ __forceinline__ void ph_mid(Frame& F) {
    const float* mods = (const float*)(F.ws + WS_MODS);
    const bf16* YO = (const bf16*)(F.ws + WS_YOB);
    float* XM = (float*)(F.ws + WS_XMID); unsigned char* H = F.ws + WS_H2B;
    int* topi = (int*)(F.ws + WS_TOPI); float* topg = (float*)(F.ws + WS_TOPG); int* elist = (int*)(F.ws + WS_ELIST);
    const float* wr = F.in[I_WR];
    constexpr int HST = 1025;
    LAS float* hs = (LAS float*)F.ldsl;
    static_assert(32 * HST * 4 <= MISC_OFF, "h stage");
    LAS int* cntl = (LAS int*)(F.ldsl + XTRA_OFF);
    LAS int* basel = cntl + 32;
    LAS int* sel = basel + 32;
    LAS int* rnk = sel + 256;
    for (int chunk = F.bid; chunk < NTOK / 64; chunk += F.G) {
        __syncthreads();
        if (F.tid < 32) cntl[F.tid] = 0;
        const int b = (chunk * 64) / SEQ;
#pragma unroll 1
        for (int hc = 0; hc < 2; ++hc) {
            __syncthreads();
#pragma unroll 1
            for (int r = 0; r < 4; ++r) {
                const int rl = F.wave * 4 + r, row = chunk * 64 + hc * 32 + rl;
                f32x4 y[4], x[4]; row_load(F.in[I_X] + (size_t)row * DM, F.lane, x);
#pragma unroll
                for (int j = 0; j < 4; ++j) { const uint2 w = *(const uint2*)(YO + (size_t)row * DM + (j * 64 + F.lane) * 4); y[j] = (f32x4){bf_lo(w.x), bf_hi(w.x), bf_lo(w.y), bf_hi(w.y)}; }
                const float ry = rsqrtf(row_sumsq(y) * (1.0f / DM) + RMS_EPS);
#pragma unroll
                for (int j = 0; j < 4; ++j) {
                    const int c0 = (j * 64 + F.lane) * 4;
                    x[j] = x[j] + *(const f32x4*)(mods + b * NMOD + 2 * DM + c0) * (y[j] * ry * *(const f32x4*)(F.in[I_GPOST] + c0));
                }
                row_store(XM + (size_t)row * DM, F.lane, x);
                const float rx = rsqrtf(row_sumsq(x) * (1.0f / DM) + RMS_EPS);
#pragma unroll
                for (int j = 0; j < 4; ++j) {
                    const int c0 = (j * 64 + F.lane) * 4;
                    const f32x4 hv = x[j] * rx * *(const f32x4*)(F.in[I_GPREF] + c0) * (1.0f + *(const f32x4*)(mods + b * NMOD + 4 * DM + c0)) + *(const f32x4*)(mods + b * NMOD + 3 * DM + c0);
                    *(unsigned*)(H + (size_t)row * DM + c0) = pk4_fp8(hv.x * H2_SCALE, hv.y * H2_SCALE, hv.z * H2_SCALE, hv.w * H2_SCALE);
                    hs[rl * HST + c0] = hv.x; hs[rl * HST + c0 + 1] = hv.y; hs[rl * HST + c0 + 2] = hv.z; hs[rl * HST + c0 + 3] = hv.w;
                }
            }
            __syncthreads();
            const int rr = F.lane & 31, eh = F.lane >> 5;
            float acc[16];
#pragma unroll
            for (int t = 0; t < 16; ++t) acc[t] = 0.f;
#pragma unroll 4
            for (int ci = 0; ci < 128; ++ci) {
                const int c = F.wave * 128 + ci;
                const float hv = hs[rr * HST + c];
                const float* wp = wr + (size_t)c * NE + eh * 16;
#pragma unroll
                for (int i = 0; i < 4; ++i) { const f32x4 w4 = *(const f32x4*)(wp + 4 * i);
#pragma unroll
                    for (int t = 0; t < 4; ++t) acc[4 * i + t] += hv * w4[t]; }
            }
            __syncthreads();
#pragma unroll
            for (int t = 0; t < 16; ++t) hs[(F.wave * 32 + rr) * 33 + eh * 16 + t] = acc[t];
            __syncthreads();
#pragma unroll 1
            for (int r = 0; r < 4; ++r) {
                const int rl = F.wave * 4 + r, rc = hc * 32 + rl, row = chunk * 64 + rc;
                float mine = -3.0e38f;
                if (F.lane < 32) { float s = F.in[I_BR][F.lane];
#pragma unroll
                    for (int w = 0; w < 8; ++w) s += hs[(w * 32 + rl) * 33 + F.lane];
                    mine = s; }
                float tv[4]; int ti[4];
#pragma unroll
                for (int k = 0; k < 4; ++k) {
                    const float mx = wave_max(mine);
                    const unsigned long long bal = __ballot(mine == mx);
                    const int idx = __ffsll((long long)bal) - 1;
                    tv[k] = mx; ti[k] = idx;
                    if (F.lane == idx) mine = -3.0e38f;
                }
                const float w1 = expf(tv[1] - tv[0]), w2 = expf(tv[2] - tv[0]), w3 = expf(tv[3] - tv[0]);
                const float inv = 1.0f / (1.0f + w1 + w2 + w3);
                const float gk[4] = {inv, w1 * inv, w2 * inv, w3 * inv};
#pragma unroll
                for (int k = 0; k < 4; ++k) {
                    if (F.lane == k) {
                        topi[row * 4 + k] = ti[k]; topg[row * 4 + k] = gk[k];
                        sel[rc * 4 + k] = ti[k];
                        rnk[rc * 4 + k] = __hip_atomic_fetch_add((int*)(cntl + ti[k]), 1, __ATOMIC_RELAXED, __HIP_MEMORY_SCOPE_WORKGROUP);
                    }
                }
            }
        }
        __syncthreads();
        if (F.tid < 32) { const int c = cntl[F.tid]; basel[F.tid] = c ? (int)atomicAdd(F.ctl + CW_ECNT + 64 * F.tid, (unsigned)c) : 0; }
        __syncthreads();
        if (F.tid < 256) { const int e = sel[F.tid]; elist[(size_t)e * NTOK + basel[e] + rnk[F.tid]] = (chunk * 64 + (F.tid >> 2)) * 4 + (F.tid & 3); }
    }
    __syncthreads();
}

__device__ __forceinline__ void p0_transpose_item(const float* W, int ldw, int k0, int n0, bf16* dst, int ldk, int rstride, LAS float* scr, int lane) {
#pragma unroll 8
    for (int i = 0; i < 32; ++i) { const int kk = 2 * i + (lane >> 5); scr[kk * 33 + (lane & 31)] = W[(size_t)(k0 + kk) * ldw + n0 + (lane & 31)]; }
    asm volatile("s_waitcnt lgkmcnt(0)" ::: "memory");
    const int c = lane & 7;
#pragma unroll
    for (int j = 0; j < 4; ++j) { const int n = (lane >> 3) + 8 * j; const LAS float* s = scr + (8 * c) * 33 + n;
        v4u o; o.x = pk2(s[0 * 33], s[1 * 33]); o.y = pk2(s[2 * 33], s[3 * 33]); o.z = pk2(s[4 * 33], s[5 * 33]); o.w = pk2(s[6 * 33], s[7 * 33]);
        *(v4u*)(dst + (size_t)n * rstride * ldk + k0 + 8 * c) = o; }
    asm volatile("s_waitcnt lgkmcnt(0)" ::: "memory");
}
__device__ __forceinline__ void p0_transpose_item_f8(const float* W, int ldw, int k0, int n0, unsigned char* dst, int ldk, float scale, LAS float* scr, int lane) {
#pragma unroll 8
    for (int i = 0; i < 32; ++i) { const int kk = 2 * i + (lane >> 5); scr[kk * 33 + (lane & 31)] = W[(size_t)(k0 + kk) * ldw + n0 + (lane & 31)]; }
    asm volatile("s_waitcnt lgkmcnt(0)" ::: "memory");
    const int c = lane & 3;
#pragma unroll
    for (int j = 0; j < 2; ++j) { const int n = (lane >> 2) + 16 * j; const LAS float* s = scr + (16 * c) * 33 + n;
        v4u o;
        o.x = pk4_fp8(s[0 * 33] * scale, s[1 * 33] * scale, s[2 * 33] * scale, s[3 * 33] * scale);
        o.y = pk4_fp8(s[4 * 33] * scale, s[5 * 33] * scale, s[6 * 33] * scale, s[7 * 33] * scale);
        o.z = pk4_fp8(s[8 * 33] * scale, s[9 * 33] * scale, s[10 * 33] * scale, s[11 * 33] * scale);
        o.w = pk4_fp8(s[12 * 33] * scale, s[13 * 33] * scale, s[14 * 33] * scale, s[15 * 33] * scale);
        *(v4u*)(dst + (size_t)n * ldk + k0 + 16 * c) = o; }
    asm volatile("s_waitcnt lgkmcnt(0)" ::: "memory");
}
__device__ __forceinline__ void ph_convert(Frame& F) {
    LAS float* scr = (LAS float*)(F.ldsl + F.wave * 16384);
    const int gw = F.bid * NWAVES + F.wave, NGW = F.G * NWAVES;
    unsigned char* WGUT = F.ws + WS_WGUT; unsigned char* WDT = F.ws + WS_WDT;
    bf16* WINT = (bf16*)(F.ws + WS_WINT); bf16* WOUTT = (bf16*)(F.ws + WS_WOUTT); bf16* WGLUT = (bf16*)(F.ws + WS_WGLUT);
    constexpr int I_IN = 16 * 40, I_OUT = 16 * 32, I_GLU = 8 * 16, I_DENSE = I_IN + I_OUT + I_GLU;
    constexpr int I_GU = 16 * 64, I_D = 16 * 32;
    for (int it = gw; it < I_DENSE + NE * (I_GU + I_D); it += NGW) {
        int r = it;
        if (r < I_IN) {
            const int kb = r / 40, nb = r % 40, n0 = nb * 32;
            if (n0 < COL_V) { const int hb = n0 & ~63, e = (n0 >> 5) & 1; p0_transpose_item(F.in[I_WIN], INW, kb * 64, n0, WINT + (size_t)(hb + e) * DM, DM, 2, scr, F.lane); }
            else p0_transpose_item(F.in[I_WIN], INW, kb * 64, n0, WINT + (size_t)n0 * DM, DM, 1, scr, F.lane);
            continue;
        }
        r -= I_IN;
        if (r < I_OUT) { const int kb = r / 32, nb = r % 32; p0_transpose_item(F.in[I_WOUT], DM, kb * 64, nb * 32, WOUTT + (size_t)nb * 32 * DM, DM, 1, scr, F.lane); continue; }
        r -= I_OUT;
        if (r < I_GLU) { const int kb = r / 16, nb = r % 16; p0_transpose_item(F.in[I_WGLU], SW, kb * 64, nb * 32, WGLUT + (size_t)nb * 32 * SW, SW, 1, scr, F.lane); continue; }
        r -= I_GLU;
        const int e = r / (I_GU + I_D); r = r % (I_GU + I_D);
        if (r < I_GU) {
            const int kb = r / 64, nb = r % 64, n0 = nb * 32;
            const int bj = n0 >> 10, pn = (n0 & 1023) >> 7, o = n0 & 127, drow = pn * 256 + bj * 128 + o;
            p0_transpose_item_f8(F.in[I_WGU] + (size_t)e * DM * 2 * DFF, 2 * DFF, kb * 64, n0, WGUT + ((size_t)e * 2 * DFF + drow) * DM, DM, W8_SCALE, scr, F.lane);
        } else {
            r -= I_GU; const int kb = r / 32, nb = r % 32, n0 = nb * 32;
            p0_transpose_item_f8(F.in[I_WD] + (size_t)e * DFF * DM, DM, kb * 64, n0, WDT + ((size_t)e * DM + n0) * DFF, DFF, W8_SCALE, scr, F.lane);
        }
    }
    float2* rope = (float2*)(F.ws + WS_ROPE);
    for (int idx = F.bid * NTHR + F.tid; idx < SEQ * 32; idx += F.G * NTHR) {
        const int i = idx & 31, pos = idx >> 5;
        const float inv = powf(10000.0f, -(float)i * (2.0f / 64.0f));
        const float ang = (float)pos * inv;
        rope[idx] = make_float2(cosf(ang), sinf(ang));
    }
}

struct DenseUnit { int pm, pn; };
struct DenseProb {
    typedef DenseUnit U;
    const char* A; const char* B; int lda_b; int K; int nN, total, G, vb;
    __device__ __forceinline__ int nt() const { return K / 64; }
    __device__ __forceinline__ bool next(int i, U& u) const { const int L = i * G + vb; if (L >= total) return false; u.pm = L / nN; u.pn = L % nN; return true; }
    __device__ __forceinline__ const char* a_base(const U& u) const { return A + (size_t)u.pm * 256 * lda_b; }
    __device__ __forceinline__ const char* b_base(const U& u) const { return B + (size_t)u.pn * 256 * K * 2; }
    __device__ __forceinline__ void a_off(const U&, int, const int (&R)[2], const int (&C)[2], unsigned (&v)[2][2]) const {
#pragma unroll
        for (int h = 0; h < 2; ++h)
#pragma unroll
            for (int i = 0; i < 2; ++i) v[h][i] = (unsigned)((h * 128 + R[i]) * lda_b + C[i] * 2);
    }
};
__device__ __forceinline__ DenseProb dense_prob(Frame& F, const void* A, int lda, const void* Bt, int M, int N, int K) {
    DenseProb S; S.A = (const char*)A; S.B = (const char*)Bt; S.lda_b = lda * 2; S.K = K; S.nN = N / 256; S.total = (M / 256) * (N / 256); S.G = F.G;
    S.vb = (F.G % 8 == 0) ? (F.bid % 8) * (F.G / 8) + F.bid / 8 : F.bid;
    return S;
}
struct EpiInProj {
    static constexpr bool PERM = true;
    bf16* O; const float* rope; bf16* UC;
    __device__ __forceinline__ void operator()(const pg8::f32x4 (&acc)[2][2][4][2], const DenseUnit& u, int, int wr, int wc, int fr, int fq) const {
#pragma unroll
        for (int bj = 0; bj < 2; ++bj) {
            const int colbase = u.pn * 256 + bj * 128, c0 = colbase + wc * 32 + 8 * fq;
            const bool isrope = colbase < COL_V; const float qs = colbase < COL_K ? 0.125f : 1.0f;
            const int i0 = (c0 & 63) >> 1;
#pragma unroll
            for (int ai = 0; ai < 2; ++ai)
#pragma unroll
                for (int m = 0; m < 4; ++m) {
                    const int row = u.pm * 256 + ai * 128 + wr * 64 + m * 16 + fr, pos = row & (SEQ - 1);
                    f32x4 v0 = acc[ai][bj][m][0], v1 = acc[ai][bj][m][1];
                    if (isrope) {
                        const f32x4 r0 = *(const f32x4*)(rope + ((size_t)pos * 32 + i0) * 2), r1 = *(const f32x4*)(rope + ((size_t)pos * 32 + i0 + 2) * 2);
                        f32x4 w0, w1;
                        w0[0] = v0[0] * r0[0] - v0[1] * r0[1]; w0[1] = v0[1] * r0[0] + v0[0] * r0[1];
                        w0[2] = v0[2] * r0[2] - v0[3] * r0[3]; w0[3] = v0[3] * r0[2] + v0[2] * r0[3];
                        w1[0] = v1[0] * r1[0] - v1[1] * r1[1]; w1[1] = v1[1] * r1[0] + v1[0] * r1[1];
                        w1[2] = v1[2] * r1[2] - v1[3] * r1[3]; w1[3] = v1[3] * r1[2] + v1[2] * r1[3];
                        v0 = w0 * qs; v1 = w1 * qs;
                    }
                    v4u w; w.x = pg8::cvt_pk_bf16(v0[0], v0[1]); w.y = pg8::cvt_pk_bf16(v0[2], v0[3]); w.z = pg8::cvt_pk_bf16(v1[0], v1[1]); w.w = pg8::cvt_pk_bf16(v1[2], v1[3]);
                    if (colbase < COL_U) *(v4u*)(O + (size_t)row * INW + c0) = w;
                    else { const int cu = c0 - COL_U, g = cu >> 4, h0 = cu & 15, b = row >> 12, t = row & (SEQ - 1);
                        *(v4u*)(UC + ((size_t)g * NRR + b * NCH + (t >> 5)) * UK + (t & 31) * CH + h0) = w; }
                }
        }
    }
};
struct EpiGlu {
    static constexpr bool PERM = true;
    const bf16* Gb; bf16* YS; const float* bglu;
    __device__ __forceinline__ void operator()(const pg8::f32x4 (&acc)[2][2][4][2], const DenseUnit& u, int, int wr, int wc, int fr, int fq) const {
#pragma unroll
        for (int bj = 0; bj < 2; ++bj) {
            const int c0 = u.pn * 256 + bj * 128 + wc * 32 + 8 * fq;
            const f32x4 b0 = *(const f32x4*)(bglu + c0), b1 = *(const f32x4*)(bglu + c0 + 4);
#pragma unroll
            for (int ai = 0; ai < 2; ++ai)
#pragma unroll
                for (int m = 0; m < 4; ++m) {
                    const size_t row = (size_t)u.pm * 256 + ai * 128 + wr * 64 + m * 16 + fr;
                    const v4u gw = *(const v4u*)(Gb + row * SW + c0);
                    const f32x4 z0 = acc[ai][bj][m][0] + b0, z1 = acc[ai][bj][m][1] + b1;
                    const float g[8] = {bf_lo(gw.x), bf_hi(gw.x), bf_lo(gw.y), bf_hi(gw.y), bf_lo(gw.z), bf_hi(gw.z), bf_lo(gw.w), bf_hi(gw.w)};
                    float o[8];
#pragma unroll
                    for (int q = 0; q < 4; ++q) { o[q] = g[q] * fast_sigmoid(z0[q]); o[4 + q] = g[4 + q] * fast_sigmoid(z1[q]); }
                    v4u w; w.x = pg8::cvt_pk_bf16(o[0], o[1]); w.y = pg8::cvt_pk_bf16(o[2], o[3]); w.z = pg8::cvt_pk_bf16(o[4], o[5]); w.w = pg8::cvt_pk_bf16(o[6], o[7]);
                    *(v4u*)(YS + row * SW + c0) = w;
                }
        }
    }
};
struct EpiStoreBf16 {
    static constexpr bool PERM = true;
    bf16* O; int ldc;
    __device__ __forceinline__ void operator()(const pg8::f32x4 (&acc)[2][2][4][2], const DenseUnit& u, int, int wr, int wc, int fr, int fq) const {
#pragma unroll
        for (int ai = 0; ai < 2; ++ai)
#pragma unroll
            for (int m = 0; m < 4; ++m) {
                const size_t row = (size_t)u.pm * 256 + ai * 128 + wr * 64 + m * 16 + fr;
#pragma unroll
                for (int bj = 0; bj < 2; ++bj) {
                    const int c0 = u.pn * 256 + bj * 128 + wc * 32 + 8 * fq;
                    const f32x4 v0 = acc[ai][bj][m][0], v1 = acc[ai][bj][m][1];
                    v4u w; w.x = pg8::cvt_pk_bf16(v0[0], v0[1]); w.y = pg8::cvt_pk_bf16(v0[2], v0[3]); w.z = pg8::cvt_pk_bf16(v1[0], v1[1]); w.w = pg8::cvt_pk_bf16(v1[2], v1[3]);
                    *(v4u*)(O + row * ldc + c0) = w;
                }
            }
    }
};

struct MoeUnit { int mt, pn, e, mloc; };
template <int MODE>
__device__ __forceinline__ void moe_setup(Frame& F) {
    LAS int* tp = (LAS int*)(F.ldsl + XT_TP); LAS int* un = (LAS int*)(F.ldsl + XT_UNITS); LAS unsigned* rowt = (LAS unsigned*)(F.ldsl + XT_ROWT);
    const int* elist = (const int*)(F.ws + WS_ELIST);
    constexpr int NT = (MODE == 1) ? 8 : 4;
    __syncthreads();
    if (F.tid == 0) { int a = 0; for (int e = 0; e < NE; ++e) { tp[e] = a; a += ((int)F.ctl[CW_ECNT + 64 * e] + 255) >> 8; } tp[32] = a; }
    __syncthreads();
    const int total = tp[32] * NT;
    const int vb = (F.G % 8 == 0) ? (F.bid % 8) * (F.G / 8) + F.bid / 8 : F.bid;
    int n = 0;
    for (int L = vb; L < total && n < MAXU; L += F.G) ++n;
    if (F.tid < n) {
        const int L = vb + F.tid * F.G, mt = L / NT, pn = L % NT;
        int e = 0;
        for (int q = 1; q < NE; ++q) if (tp[q] <= mt) e = q;
        un[F.tid * 4 + 0] = mt; un[F.tid * 4 + 1] = pn; un[F.tid * 4 + 2] = e; un[F.tid * 4 + 3] = mt - tp[e];
    }
    if (F.tid == 0) tp[34] = n;
    __syncthreads();
    for (int j = 0; j < n; ++j) {
        if (F.tid < 256) {
            const int e = un[j * 4 + 2], mloc = un[j * 4 + 3], idx = mloc * 256 + F.tid;
            const int cnt = (int)F.ctl[CW_ECNT + 64 * e];
            const int a = idx < cnt ? elist[(size_t)e * NTOK + idx] : -1;
            rowt[j * 256 + F.tid] = (MODE == 1) ? (a >= 0 ? (unsigned)(a >> 2) * (unsigned)DM : 0u) : (unsigned)a;
        }
    }
    __syncthreads();
}
template <int MODE> struct MoeProb {
    typedef MoeUnit U;
    LAS unsigned char* l; const char* A; const char* B;
    __device__ __forceinline__ int nt() const { return 8; }
    __device__ __forceinline__ bool next(int i, U& u) const {
        const LAS int* tp = (const LAS int*)(l + XT_TP); const LAS int* un = (const LAS int*)(l + XT_UNITS);
        const int n = __builtin_amdgcn_readfirstlane(tp[34]);
        if (i >= n) return false;
        u.mt = __builtin_amdgcn_readfirstlane(un[i * 4 + 0]); u.pn = __builtin_amdgcn_readfirstlane(un[i * 4 + 1]);
        u.e = __builtin_amdgcn_readfirstlane(un[i * 4 + 2]); u.mloc = __builtin_amdgcn_readfirstlane(un[i * 4 + 3]);
        return true;
    }
    __device__ __forceinline__ const char* a_base(const U& u) const { return MODE == 1 ? A : A + (size_t)u.mt * 256 * DFF; }
    __device__ __forceinline__ const char* b_base(const U& u) const { return MODE == 1 ? B + ((size_t)u.e * 2 * DFF + u.pn * 256) * DM : B + ((size_t)u.e * DM + u.pn * 256) * DFF; }
    __device__ __forceinline__ void a_off(const U&, int ui, const int (&R)[2], const int (&C)[2], unsigned (&v)[2][2]) const {
        const LAS unsigned* rowt = (const LAS unsigned*)(l + XT_ROWT) + ui * 256;
#pragma unroll
        for (int h = 0; h < 2; ++h)
#pragma unroll
            for (int i = 0; i < 2; ++i) v[h][i] = (MODE == 1) ? rowt[h * 128 + R[i]] + (unsigned)C[i] * 2u : (unsigned)((h * 128 + R[i]) * DFF + C[i] * 2);
    }
};
struct EpiGateUp {
    static constexpr bool PERM = true;
    unsigned char* ACT; const float* bgu;
    __device__ __forceinline__ void operator()(const pg8::f32x4 (&acc)[2][2][4][2], const MoeUnit& u, int, int wr, int wc, int fr, int fq) const {
        constexpr float DS = 1.0f / (H2_SCALE * W8_SCALE);
        const float* bias = bgu + (size_t)u.e * 2 * DFF; const int j0 = u.pn * 128 + wc * 32 + 8 * fq;
#pragma unroll
        for (int n = 0; n < 2; ++n) {
            const f32x4 bg = *(const f32x4*)(bias + j0 + 4 * n), bl = *(const f32x4*)(bias + DFF + j0 + 4 * n);
#pragma unroll
            for (int ai = 0; ai < 2; ++ai)
#pragma unroll
                for (int m = 0; m < 4; ++m) {
                    const size_t row = (size_t)u.mt * 256 + ai * 128 + wr * 64 + m * 16 + fr;
                    const f32x4 g0 = acc[ai][0][m][n] * DS + bg, l0 = acc[ai][1][m][n] * DS + bl;
                    float o[4];
#pragma unroll
                    for (int q = 0; q < 4; ++q) { const float g = fminf(g0[q], 7.0f), l = fminf(fmaxf(l0[q], -7.0f), 7.0f); o[q] = g * fast_sigmoid(1.702f * g) * (l + 1.0f) * ACT_SCALE; }
                    *(unsigned*)(ACT + row * DFF + j0 + 4 * n) = pk4_fp8(o[0], o[1], o[2], o[3]);
                }
        }
    }
};
struct EpiDown {
    static constexpr bool PERM = true;
    bf16* YB; const float* bd; LAS unsigned char* l;
    __device__ __forceinline__ void operator()(const pg8::f32x4 (&acc)[2][2][4][2], const MoeUnit& u, int ui, int wr, int wc, int fr, int fq) const {
        const LAS int* rowt = (const LAS int*)(l + XT_ROWT) + ui * 256;
        const float* bias = bd + (size_t)u.e * DM; const int c0 = u.pn * 256 + wc * 32 + 8 * fq;
        f32x4 b0[2], b1[2];
#pragma unroll
        for (int bj = 0; bj < 2; ++bj) { b0[bj] = *(const f32x4*)(bias + c0 + bj * 128); b1[bj] = *(const f32x4*)(bias + c0 + bj * 128 + 4); }
#pragma unroll
        for (int ai = 0; ai < 2; ++ai)
#pragma unroll
            for (int m = 0; m < 4; ++m) {
                const int a = rowt[ai * 128 + wr * 64 + m * 16 + fr];
                v4u w[2];
#pragma unroll
                for (int bj = 0; bj < 2; ++bj) {
                    constexpr float DS = 1.0f / (ACT_SCALE * W8_SCALE);
                    const f32x4 v0 = acc[ai][bj][m][0] * DS + b0[bj], v1 = acc[ai][bj][m][1] * DS + b1[bj];
                    w[bj].x = pg8::cvt_pk_bf16(v0[0], v0[1]); w[bj].y = pg8::cvt_pk_bf16(v0[2], v0[3]); w[bj].z = pg8::cvt_pk_bf16(v1[0], v1[1]); w[bj].w = pg8::cvt_pk_bf16(v1[2], v1[3]);
                }
                if (a >= 0) { *(v4u*)(YB + (size_t)a * DM + c0) = w[0]; *(v4u*)(YB + (size_t)a * DM + c0 + 128) = w[1]; }
            }
    }
};
template <int MODE>
__device__ __forceinline__ void ph_moe(Frame& F) {
    moe_setup<MODE>(F);
    if (MODE == 1) {
        MoeProb<1> S{F.ldsl, (const char*)(F.ws + WS_H2B), (const char*)(F.ws + WS_WGUT)};
        EpiGateUp E{F.ws + WS_ACT, F.in[I_BGU]};
        pg8::gemm_phase<MoeProb<1>, EpiGateUp, true, true>(F.ldsl, S, E);
    } else {
        MoeProb<2> S{F.ldsl, (const char*)(F.ws + WS_ACT), (const char*)(F.ws + WS_WDT)};
        EpiDown E{(bf16*)(F.ws + WS_YB), F.in[I_BD], F.ldsl};
        pg8::gemm_phase<MoeProb<2>, EpiDown, true, true>(F.ldsl, S, E);
    }
    __syncthreads();
}

__device__ __forceinline__ void ph_final(Frame& F) {
    const float* mods = (const float*)(F.ws + WS_MODS);
    const float* XM = (const float*)(F.ws + WS_XMID); const bf16* YB = (const bf16*)(F.ws + WS_YB);
    const float* topg = (const float*)(F.ws + WS_TOPG);
    for (int row = F.bid * NWAVES + F.wave; row < NTOK; row += F.G * NWAVES) {
        const int b = row / SEQ;
        f32x4 y[4];
#pragma unroll
        for (int j = 0; j < 4; ++j) y[j] = (f32x4){0.f, 0.f, 0.f, 0.f};
#pragma unroll
        for (int k = 0; k < 4; ++k) {
            const float gk = topg[row * 4 + k];
            const bf16* yr = YB + (size_t)(row * 4 + k) * DM;
#pragma unroll
            for (int j = 0; j < 4; ++j) { const uint2 w = *(const uint2*)(yr + (j * 64 + F.lane) * 4);
                y[j] += gk * (f32x4){bf_lo(w.x), bf_hi(w.x), bf_lo(w.y), bf_hi(w.y)}; }
        }
        const float ry = rsqrtf(row_sumsq(y) * (1.0f / DM) + RMS_EPS);
        f32x4 x[4]; row_load(XM + (size_t)row * DM, F.lane, x);
#pragma unroll
        for (int j = 0; j < 4; ++j) {
            const int c0 = (j * 64 + F.lane) * 4;
            x[j] = x[j] + *(const f32x4*)(mods + b * NMOD + 5 * DM + c0) * (y[j] * ry * *(const f32x4*)(F.in[I_GPOSTF] + c0));
        }
        row_store(F.out + (size_t)row * DM, F.lane, x);
    }
}

constexpr int NPH = 13;
struct Args { const float* in[29]; float* out; unsigned char* ws; int ph_lo, ph_hi; };

__device__ __forceinline__ GrpProb grp_prob(Frame& F, const void* A, size_t a_gs, int lda, int K, const void* B, size_t b_gs, int N) {
    GrpProb S; S.A = (const char*)A; S.B = (const char*)B; S.a_gs = a_gs; S.b_gs = b_gs; S.lda_b = lda * 2; S.K = K; S.nN = N / 256; S.total = NG * 2 * (N / 256); S.G = F.G;
    S.vb = (F.G % 8 == 0) ? (F.bid % 8) * (F.G / 8) + F.bid / 8 : F.bid;
    return S;
}

__global__ void __launch_bounds__(NTHR, 2) fwd_kernel(Args args) {
    extern __shared__ __attribute__((aligned(16))) unsigned char lds[];
    Frame F;
    F.lds = lds; F.ldsl = (LAS unsigned char*)lds;
    F.tid = threadIdx.x; F.lane = F.tid & 63; F.wave = __builtin_amdgcn_readfirstlane(F.tid >> 6);
    F.bid = blockIdx.x; F.G = gridDim.x;
#pragma unroll
    for (int i = 0; i < 29; ++i) F.in[i] = args.in[i];
    F.out = args.out; F.ws = args.ws; F.ctl = (unsigned*)(args.ws + WS_CTL);
    volatile LAS unsigned* MISC = (volatile LAS unsigned*)((LAS unsigned char*)lds + MISC_OFF);
    if (F.tid < 32) MISC[F.tid] = 0u;
    __syncthreads();
    XcdBarrier bar; bar.bar = F.ctl + CW_BAR; bar.x = 0; bar.st = nullptr;
    if (MK_N_LAUNCHES == 1) bar = xcd_barrier_post(F.ctl + CW_BAR, MISC + 8);
    const int lo = args.ph_lo, hi = args.ph_hi;
#define IN(k) (lo <= (k) && (k) < hi)
#define SEAM(k) do { if (MK_N_LAUNCHES == 1 && IN(k) && IN((k) + 1)) xcd_barrier(bar); } while (0)
#define PHASE(k, ...) do { if (IN(k)) { __VA_ARGS__ } SEAM(k); if ((DUP_MASK >> (k)) & 1) { if (IN(k)) { __VA_ARGS__ } if (MK_N_LAUNCHES == 1) xcd_barrier(bar); } } while (0)
    PHASE(0, ph_mods(F); ph_convert(F););
    PHASE(1, ph_h1(F););
    PHASE(2,
        DenseProb S = dense_prob(F, F.ws + WS_H1B, DM, F.ws + WS_WINT, NTOK, INW, DM);
        EpiInProj E{(bf16*)(F.ws + WS_PROJB), (const float*)(F.ws + WS_ROPE), (bf16*)(F.ws + WS_UCAT)};
        pg8::gemm_phase<DenseProb, EpiInProj, true>(F.ldsl, S, E); __syncthreads(););
    PHASE(3,
        ph_attn(F);
        GrpProb S = grp_prob(F, F.ws + WS_UCAT, (size_t)NRR * UK * 2, UK, UK_U, F.ws + WS_WE, (size_t)256 * 512 * 2, 256);
        EpiEst E{(float*)(F.ws + WS_EST)};
        pg8::gemm_phase<GrpProb, EpiEst, true>(F.ldsl, S, E); __syncthreads(););
    PHASE(4, ph_scan(F););
    PHASE(5,
        GrpProb S = grp_prob(F, F.ws + WS_UCAT, (size_t)NRR * UK * 2, UK, UK, F.ws + WS_WY, (size_t)512 * UK * 2, 512);
        EpiSsmY E{(bf16*)(F.ws + WS_GB)};
        pg8::gemm_phase<GrpProb, EpiSsmY, true>(F.ldsl, S, E); __syncthreads(););
    PHASE(6,
        DenseProb S = dense_prob(F, F.ws + WS_GB, SW, F.ws + WS_WGLUT, NTOK, SW, SW);
        EpiGlu E{(const bf16*)(F.ws + WS_GB), (bf16*)(F.ws + WS_YSB), F.in[I_BGLU]};
        pg8::gemm_phase<DenseProb, EpiGlu, true>(F.ldsl, S, E); __syncthreads(););
    PHASE(7, ph_cat(F););
    PHASE(8,
        DenseProb S = dense_prob(F, F.ws + WS_YCATB, DM, F.ws + WS_WOUTT, NTOK, DM, DM);
        EpiStoreBf16 E{(bf16*)(F.ws + WS_YOB), DM};
        pg8::gemm_phase<DenseProb, EpiStoreBf16, true>(F.ldsl, S, E); __syncthreads(););
    PHASE(9, ph_mid(F););
    PHASE(10, ph_moe<1>(F););
    PHASE(11, ph_moe<2>(F););
    if (IN(12)) { ph_final(F); }
    if ((DUP_MASK >> 12) & 1) { if (MK_N_LAUNCHES == 1) xcd_barrier(bar); ph_final(F); }
#undef PHASE
#undef IN
#undef SEAM
}

extern "C" void kernel_launch(void* const* d_in, const int* in_sizes, int n_in, void* d_out, int out_size, void* d_ws, size_t ws_size, hipStream_t stream) {
    static int grid = 0;
    if (grid == 0) {
        if (n_in != 29 || ws_size < WS_END) { fprintf(stderr, "kernel_launch: unexpected n_in %d / ws %zu\n", n_in, ws_size); grid = -1; return; }
        int dev = 0, cus = 0, per_cu = 0;
        if (hipGetDevice(&dev) != hipSuccess || hipDeviceGetAttribute(&cus, hipDeviceAttributeMultiprocessorCount, dev) != hipSuccess) { grid = -1; return; }
        if (hipFuncSetAttribute((const void*)fwd_kernel, hipFuncAttributeMaxDynamicSharedMemorySize, LDS_BYTES) != hipSuccess) { fprintf(stderr, "kernel_launch: hipFuncSetAttribute failed\n"); grid = -1; return; }
        if (hipOccupancyMaxActiveBlocksPerMultiprocessor(&per_cu, (const void*)fwd_kernel, NTHR, LDS_BYTES) != hipSuccess || per_cu < 1)
            fprintf(stderr, "kernel_launch: occupancy query reports %d\n", per_cu);
        (void)hipGetLastError();
        grid = cus;
    }
    if (grid < 0) return;
    (void)hipMemsetAsync((char*)d_ws + WS_CTL, 0, CTL_ZERO_BYTES, stream);
    Args a{};
    for (int i = 0; i < 29; ++i) a.in[i] = (const float*)d_in[i];
    a.out = (float*)d_out; a.ws = (unsigned char*)d_ws;
    if (MK_N_LAUNCHES == 1) {
        a.ph_lo = 0; a.ph_hi = NPH;
        hipLaunchKernelGGL(fwd_kernel, dim3(grid), dim3(NTHR), LDS_BYTES, stream, a);
    } else {
        for (int p = 0; p < NPH; ++p) {
            a.ph_lo = p; a.ph_hi = p + 1;
            hipLaunchKernelGGL(fwd_kernel, dim3(grid), dim3(NTHR), LDS_BYTES, stream, a);
        }
    }
}
```
